# Optimizing an MI355X kernel written in HIP

```python
import jax, jax.numpy as jnp
from jax import lax
import numpy as np

D_MODEL = 1024
BATCH = 16
SEQ = 2048
DEPTH = 4

HEAD_DIM = 64
HEADS_PER_GROUP = D_MODEL // 256
DILATED_GROUPS = ((128, 1), (512, 4), (2048, 16))
N_ATTN_GROUPS = len(DILATED_GROUPS)
ATTN_WIDTH = N_ATTN_GROUPS * HEADS_PER_GROUP * HEAD_DIM
ATTN_OUT_WIDTH = HEADS_PER_GROUP * HEAD_DIM
ROPE_DIM = HEAD_DIM // 4
ROPE_THETA = 500000.0
MASK_VALUE = -1e30
POOL_WINDOWS = (2, 4, 8, 16)
N_POOL_GROUPS = len(POOL_WINDOWS)
POOL_WIDTH = D_MODEL // 2
POOL_GROUP_DIM = POOL_WIDTH // N_POOL_GROUPS
IN_COLS = 3 * ATTN_WIDTH + POOL_WIDTH + 2 * D_MODEL
N_EXPERTS = 32
TOP_K = 4
D_FF_EXPERT = D_MODEL
SWIGLU_ALPHA = 1.702
SWIGLU_LIMIT = 7.0
MOE_BLOCK = 128
NORM_EPS = 1e-5

kernel_name = "hybrid_dilated_pool_moe_encoder"


def rmsnorm(x, g):
    xf = x.astype(jnp.float32)
    y = xf * lax.rsqrt(jnp.mean(xf * xf, axis=-1, keepdims=True) + NORM_EPS)
    return (y * g.astype(jnp.float32)).astype(x.dtype)


def rope_tables(S):
    inv = ROPE_THETA ** (-jnp.arange(0, ROPE_DIM, 2, dtype=jnp.float32) / ROPE_DIM)
    ang = jnp.arange(S, dtype=jnp.float32)[:, None] * inv[None, :]
    return jnp.cos(ang), jnp.sin(ang)


def apply_partial_rope(t, cos, sin):
    half = ROPE_DIM // 2
    tf = t[..., :ROPE_DIM].astype(jnp.float32)
    t1, t2 = tf[..., :half], tf[..., half:]
    c = cos[None, :, None, None, :]
    s = sin[None, :, None, None, :]
    rot = jnp.concatenate([t1 * c - t2 * s, t2 * c + t1 * s], axis=-1).astype(t.dtype)
    return jnp.concatenate([rot, t[..., ROPE_DIM:]], axis=-1)


def dilated_window_attention(q, k, v, window, dilation):
    B, S, H, Dh = q.shape
    n_side = window // (2 * dilation)
    blk = n_side
    L = S // dilation
    nb = -(-L // blk)
    Lp = nb * blk

    def residue(t):
        return t.reshape(B, L, dilation, H, Dh).transpose(0, 2, 1, 3, 4)

    qr, kr, vr = residue(q), residue(k), residue(v)
    qb = jnp.pad(qr, ((0, 0), (0, 0), (0, Lp - L), (0, 0), (0, 0))).reshape(B, dilation, nb, blk, H, Dh)

    def key_windows(t):
        tp = jnp.pad(t, ((0, 0), (0, 0), (blk, blk + Lp - L), (0, 0), (0, 0)))
        tp = tp.reshape(B, dilation, nb + 2, blk, H, Dh)
        return jnp.concatenate([tp[:, :, :-2], tp[:, :, 1:-1], tp[:, :, 2:]], axis=3)

    kw, vw = key_windows(kr), key_windows(vr)
    scores = jnp.einsum('brnqhd,brnkhd->brnhqk', qb, kw,
                        preferred_element_type=jnp.float32) * (Dh ** -0.5)
    qpos = jnp.arange(nb)[:, None] * blk + jnp.arange(blk)[None, :]
    kpos = jnp.arange(nb)[:, None] * blk - blk + jnp.arange(3 * blk)[None, :]
    rel = kpos[:, None, :] - qpos[:, :, None]
    valid = (jnp.abs(rel) <= n_side) & (kpos[:, None, :] >= 0) & (kpos[:, None, :] < L)
    scores = jnp.where(valid[None, None, :, None], scores, MASK_VALUE)
    lse = jax.nn.logsumexp(scores, axis=-1)
    probs = jnp.exp(scores - lse[..., None])
    out = jnp.einsum('brnhqk,brnkhd->brnqhd', probs.astype(v.dtype), vw)
    out = out.reshape(B, dilation, Lp, H, Dh)[:, :, :L].transpose(0, 2, 1, 3, 4).reshape(B, S, H, Dh)
    lse = lse.transpose(0, 1, 2, 4, 3).reshape(B, dilation, Lp, H)[:, :, :L]
    lse = lse.transpose(0, 2, 1, 3).reshape(B, S, H)
    return out, lse


def multiscale_pool(u, pool_w, pool_scale):
    B, S, _ = u.shape
    uf = u.astype(jnp.float32).reshape(B, S, N_POOL_GROUPS, POOL_GROUP_DIM)
    csum = jnp.concatenate([jnp.zeros_like(uf[:, :1]), jnp.cumsum(uf, axis=1)], axis=1)
    half = jnp.array(POOL_WINDOWS, dtype=jnp.int32) // 2
    pos = jnp.arange(S, dtype=jnp.int32)[:, None]
    lo = jnp.clip(pos - half[None, :], 0, S)
    hi = jnp.clip(pos + half[None, :], 0, S)
    gidx = jnp.arange(N_POOL_GROUPS)[None, :]
    window_sum = csum[:, hi, gidx] - csum[:, lo, gidx]
    mean = window_sum / (hi - lo).astype(jnp.float32)[None, :, :, None]
    y = jnp.einsum('bsgc,gcd->bsgd', mean - uf, pool_w.astype(jnp.float32))
    return (y.reshape(B, S, POOL_WIDTH) * pool_scale.astype(jnp.float32)).astype(u.dtype)


def hybrid_mixer(h, w_in, pool_w, pool_scale, w_attn_branch, w_pool_branch, w_out, cos, sin):
    B, S, _ = h.shape
    proj = h @ w_in
    splits = np.cumsum([ATTN_WIDTH, ATTN_WIDTH, ATTN_WIDTH, POOL_WIDTH, D_MODEL]).tolist()
    q, k, v, u, gate_a, gate_p = jnp.split(proj, splits, axis=-1)

    def heads(t):
        return t.reshape(B, S, N_ATTN_GROUPS, HEADS_PER_GROUP, HEAD_DIM)

    q = apply_partial_rope(heads(q), cos, sin)
    k = apply_partial_rope(heads(k), cos, sin)
    v = heads(v)
    outs, lses = [], []
    for g, (window, dilation) in enumerate(DILATED_GROUPS):
        o_g, lse_g = dilated_window_attention(q[:, :, g], k[:, :, g], v[:, :, g], window, dilation)
        outs.append(o_g)
        lses.append(lse_g)
    alpha = jax.nn.softmax(jnp.stack(lses, axis=0), axis=0)
    attn = jnp.einsum('gbsh,gbshd->bshd', alpha, jnp.stack(outs, axis=0).astype(jnp.float32))
    attn = attn.reshape(B, S, ATTN_OUT_WIDTH).astype(h.dtype)
    pool = multiscale_pool(u, pool_w, pool_scale)
    merged = (jax.nn.sigmoid(gate_a) * (attn @ w_attn_branch)
              + jax.nn.sigmoid(gate_p) * (pool @ w_pool_branch))
    return merged @ w_out


def clamped_swiglu(z):
    glu, lin = z[..., :D_FF_EXPERT], z[..., D_FF_EXPERT:]
    glu = jnp.minimum(glu, SWIGLU_LIMIT)
    lin = jnp.clip(lin, -SWIGLU_LIMIT, SWIGLU_LIMIT)
    return glu * jax.nn.sigmoid(SWIGLU_ALPHA * glu) * (lin + 1)


def moe_ffn(h, router_w, router_b, w_gu, b_gu, w_down, b_down):
    B, S, D = h.shape
    T = B * S
    tokens = h.reshape(T, D)
    logits = (tokens @ router_w).astype(jnp.float32) + router_b.astype(jnp.float32)
    top_logits, top_idx = lax.top_k(logits, TOP_K)
    gates = jax.nn.softmax(top_logits, axis=-1)
    n_assign = T * TOP_K
    flat_e = top_idx.reshape(n_assign)
    order = jnp.argsort(flat_e)
    sorted_e = flat_e[order]
    counts = jnp.bincount(flat_e, length=N_EXPERTS)
    padded = (counts + MOE_BLOCK - 1) // MOE_BLOCK * MOE_BLOCK
    padded_end = jnp.cumsum(padded)
    start = jnp.cumsum(counts) - counts
    dest = (padded_end - padded)[sorted_e] + jnp.arange(n_assign) - start[sorted_e]
    n_blocks = -(-n_assign // MOE_BLOCK) + N_EXPERTS
    n_rows = n_blocks * MOE_BLOCK
    row_token = jnp.full((n_rows,), T, dtype=jnp.int32).at[dest].set((order // TOP_K).astype(jnp.int32))
    row_gate = jnp.zeros((n_rows,), jnp.float32).at[dest].set(gates.reshape(n_assign)[order])
    block_expert = jnp.minimum(
        jnp.searchsorted(padded_end, jnp.arange(n_blocks) * MOE_BLOCK, side='right'), N_EXPERTS - 1)
    tokens_pad = jnp.concatenate([tokens, jnp.zeros((1, D), tokens.dtype)], axis=0)
    x_rows = tokens_pad[row_token].reshape(n_blocks, MOE_BLOCK, D)

    def expert_block(args):
        xb, e = args
        z = xb @ w_gu[e] + b_gu[e]
        return clamped_swiglu(z) @ w_down[e] + b_down[e]

    y = lax.map(expert_block, (x_rows, block_expert)).reshape(n_rows, D)
    out = jnp.zeros((T + 1, D), jnp.float32).at[row_token].add(y.astype(jnp.float32) * row_gate[:, None])
    return out[:T].astype(h.dtype).reshape(B, S, D)


def setup_inputs(seed: int = 0) -> dict:
    key = jax.random.key(seed)
    ks = jax.random.split(key, 20)

    def nrm(k, shape, scale):
        return jax.random.normal(k, shape, jnp.float32) * scale

    return {
        "x": nrm(ks[0], (BATCH, SEQ, D_MODEL), 1.0),
        "c": nrm(ks[1], (BATCH, D_MODEL), 1.0),
        "ada_w": nrm(ks[2], (DEPTH, D_MODEL, 6 * D_MODEL), 0.5 * D_MODEL ** -0.5),
        "ada_b": nrm(ks[3], (DEPTH, 6 * D_MODEL), 0.01),
        "norm1_g": 1.0 + nrm(ks[4], (DEPTH, D_MODEL), 0.05),
        "w_in": nrm(ks[5], (DEPTH, D_MODEL, IN_COLS), D_MODEL ** -0.5),
        "pool_w": nrm(ks[6], (DEPTH, N_POOL_GROUPS, POOL_GROUP_DIM, POOL_GROUP_DIM), POOL_GROUP_DIM ** -0.5),
        "pool_scale": 1.0 + nrm(ks[7], (DEPTH, POOL_WIDTH), 0.05),
        "w_attn_branch": nrm(ks[8], (DEPTH, ATTN_OUT_WIDTH, D_MODEL), ATTN_OUT_WIDTH ** -0.5),
        "w_pool_branch": nrm(ks[9], (DEPTH, POOL_WIDTH, D_MODEL), POOL_WIDTH ** -0.5),
        "w_out": nrm(ks[10], (DEPTH, D_MODEL, D_MODEL), D_MODEL ** -0.5),
        "norm2_g": 1.0 + nrm(ks[11], (DEPTH, D_MODEL), 0.05),
        "router_w": nrm(ks[12], (DEPTH, D_MODEL, N_EXPERTS), D_MODEL ** -0.5),
        "router_b": nrm(ks[13], (DEPTH, N_EXPERTS), 0.01),
        "w_gu": nrm(ks[14], (DEPTH, N_EXPERTS, D_MODEL, 2 * D_FF_EXPERT), D_MODEL ** -0.5),
        "b_gu": nrm(ks[15], (DEPTH, N_EXPERTS, 2 * D_FF_EXPERT), 0.01),
        "w_down": nrm(ks[16], (DEPTH, N_EXPERTS, D_FF_EXPERT, D_MODEL), D_FF_EXPERT ** -0.5),
        "b_down": nrm(ks[17], (DEPTH, N_EXPERTS, D_MODEL), 0.01),
        "final_g": 1.0 + nrm(ks[18], (D_MODEL,), 0.05),
    }


def reference(x, c, ada_w, ada_b, norm1_g, w_in, pool_w, pool_scale, w_attn_branch,
              w_pool_branch, w_out, norm2_g, router_w, router_b, w_gu, b_gu, w_down,
              b_down, final_g):
    S = x.shape[1]
    cos, sin = rope_tables(S)
    c_act = jax.nn.silu(c)
    for l in range(DEPTH):
        mod = c_act @ ada_w[l] + ada_b[l]
        sh1, sc1, g1, sh2, sc2, g2 = [m[:, None, :] for m in jnp.split(mod, 6, axis=-1)]
        h = rmsnorm(x, norm1_g[l]) * (1 + sc1) + sh1
        x = x + g1 * hybrid_mixer(h, w_in[l], pool_w[l], pool_scale[l], w_attn_branch[l],
                                  w_pool_branch[l], w_out[l], cos, sin)
        h = rmsnorm(x, norm2_g[l]) * (1 + sc2) + sh2
        x = x + g2 * moe_ffn(h, router_w[l], router_b[l], w_gu[l], b_gu[l], w_down[l], b_down[l])
    return rmsnorm(x, final_g)
```

```cpp
#include <hip/hip_runtime.h>
#include <cstdint>
#include <cstdio>

#ifndef MODE
#define MODE 0
#endif

#ifndef DUP_K
#define DUP_K (-1)
#endif
#ifndef X_BF16
#define X_BF16 1
#endif
#ifndef TAIL_B
#define TAIL_B 3
#define TAIL_J 1
#define TAIL_K 2
#endif
#ifndef MOE_FP8
#define MOE_FP8 1
#ifndef P16_MASK
#define P16_MASK 31
#endif
#ifndef DRAIN_STATIC
#define DRAIN_STATIC 0
#endif
#define Y_FP8 1
#define GATE_U8 1
#define G_FP8 1
#define B_FP8 1
#endif
#define REP(k) _Pragma("unroll 1") for (int rep_ = 0, nrep_ = ((DUP_K == (k)) ? mk::opaque_s(2) : 1); rep_ < nrep_; ++rep_)
#define LAS __attribute__((address_space(3)))
#define GAS __attribute__((address_space(1)))

namespace mk {
constexpr int D = 1024, NB = 16, S = 2048, T = NB * S, DEPTH = 4;
constexpr int IN_COLS = 4864;
constexpr int NE = 32, TOPK = 4, NASSIGN = T * TOPK, RPAD = 256, NROWS_MAX = NASSIGN + NE * RPAD;
constexpr float EPS = 1e-5f;
constexpr float YSCALE = 32.f;
constexpr float HSCALE = 16.f, WSCALE = 256.f, ASCALE = 8.f;
constexpr int EB = MOE_FP8 ? 1 : 2;
constexpr int NWAVES = 8, NTHREADS = 512, GRID = 256, TPB = T / GRID;

typedef unsigned short bf16;
typedef short bf16x8 __attribute__((ext_vector_type(8)));
typedef short s16x4 __attribute__((ext_vector_type(4)));
typedef float f32x2 __attribute__((ext_vector_type(2)));
typedef float f32x4 __attribute__((ext_vector_type(4)));
typedef float f32x16 __attribute__((ext_vector_type(16)));
typedef unsigned u32x2 __attribute__((ext_vector_type(2)));
typedef unsigned u32x4 __attribute__((ext_vector_type(4)));
typedef __bf16 bf16x2_t __attribute__((ext_vector_type(2)));

__device__ __forceinline__ unsigned pk2(float lo, float hi) { f32x2 v = {lo, hi}; bf16x2_t b = __builtin_convertvector(v, bf16x2_t); return __builtin_bit_cast(unsigned, b); }
__device__ __forceinline__ int opaque_s(int v);
#define KF(x) __builtin_bit_cast(float, mk::opaque_s(__builtin_bit_cast(int, (float)(x))))
__device__ __forceinline__ float fexp(float x) { return __builtin_amdgcn_exp2f(x * KF(1.4426950408889634f)); }
__device__ __forceinline__ float flog(float x) { return __builtin_amdgcn_logf(x) * KF(0.6931471805599453f); }
template <bool CLAMP = true>
__device__ __forceinline__ unsigned pk4_fp8(float a, float b, float c, float d) {
    if (CLAMP) { const float hi = KF(448.f), lo = -hi; a = fminf(fmaxf(a, lo), hi); b = fminf(fmaxf(b, lo), hi); c = fminf(fmaxf(c, lo), hi); d = fminf(fmaxf(d, lo), hi); }
    int p = 0; p = __builtin_amdgcn_cvt_pk_fp8_f32(a, b, p, false); p = __builtin_amdgcn_cvt_pk_fp8_f32(c, d, p, true); return (unsigned)p; }
__device__ __forceinline__ float bflo(unsigned u) { return __builtin_bit_cast(float, u << 16); }
__device__ __forceinline__ float bfhi(unsigned u) { return __builtin_bit_cast(float, u & 0xffff0000u); }
__device__ __forceinline__ float fsigmoid(float x) { return __builtin_amdgcn_rcpf(1.f + __builtin_amdgcn_exp2f(-1.4426950408889634f * x)); }
__device__ __forceinline__ int lane_id() { int l; asm volatile("v_mbcnt_lo_u32_b32 %0, -1, 0\n\tv_mbcnt_hi_u32_b32 %0, -1, %0" : "=v"(l)); return l; }
__device__ __forceinline__ int opaque_s(int v) { asm volatile("" : "+s"(v)); return v; }
__device__ __forceinline__ int opaque(int v) { asm volatile("" : "+v"(v)); return v; }
__device__ __forceinline__ f32x4 xload4(const void* X, size_t idx, bool f32src) {
    if (f32src || !X_BF16) return *(const f32x4*)((const float*)X + idx);
    const u32x2 w = *(const u32x2*)((const unsigned short*)X + idx); return (f32x4){bflo(w.x), bfhi(w.x), bflo(w.y), bfhi(w.y)};
}
__device__ __forceinline__ void xstore4(void* X, size_t idx, const f32x4 v) {
    if (!X_BF16) { *(f32x4*)((float*)X + idx) = v; return; }
    u32x2 w; w.x = pk2(v[0], v[1]); w.y = pk2(v[2], v[3]); *(u32x2*)((unsigned short*)X + idx) = w;
}
__device__ __forceinline__ float wave_sum(float v) {
#pragma unroll
    for (int o = 1; o < 64; o <<= 1) v += __shfl_xor(v, o);
    return v;
}

constexpr int BM = 256, BK = 64, HALF = 128, HTB = HALF * BK * 2, STAGE_BYTES = 8 * HTB, NXCD = 8, WGM = 8;
__host__ __device__ __forceinline__ int lds_byte(int r, int c) { const int st = (r >> 4) * 2 + (c >> 5), rr = r & 15, cc = c & 31, ob = rr * 64 + cc * 2; return st * 1024 + (ob ^ (((ob >> 9) & 1) << 5)); }
__host__ __device__ __forceinline__ void stage_rc(int b, int& R, int& C) { const int st = b / 1024, sb = b % 1024, swz = sb ^ (((sb >> 9) & 1) << 5); R = (st >> 1) * 16 + swz / 64; C = (st & 1) * 32 + (swz % 64) / 2; }
__host__ __device__ __forceinline__ int perm32(int rho) { const int n = rho >> 4, i = rho & 15; return 8 * (i >> 2) + 4 * n + (i & 3); }

struct Unit { int pm, pn, e; };
struct StaticOrder {
    int nM, nN, nwg, G, c, wgm; bool colfast;
    __device__ void init(int nM_, int nN_, int G_, int c_, bool colfast_ = false, int wgm_ = WGM) { nM = nM_; nN = nN_; nwg = nM * nN; G = G_; c = c_; colfast = colfast_; wgm = wgm_; }
    __device__ bool next(int i, Unit& u) const {
        const long L = (long)i * G + c; if (L >= nwg) return false;
        int wgid = (int)L; { const int q = nwg / NXCD, r = nwg % NXCD, xcd = wgid % NXCD, off = wgid / NXCD; wgid = (xcd < r ? xcd * (q + 1) : r * (q + 1) + (xcd - r) * q) + off; }
        const int nig = wgm * nN, gid = wgid / nig, fm = gid * wgm, gsz = (nM - fm) < wgm ? (nM - fm) : wgm;
        const int w = wgid % nig;
        if (colfast) { u.pm = fm + w / nN; u.pn = w % nN; } else { u.pm = fm + (w % gsz); u.pn = w / gsz; }
        u.e = 0; return true;
    }
};
struct DenseSched {
    static constexpr bool GATHER = false;
    StaticOrder so; const char* A; const char* Bt; int lda, K;
    __device__ __forceinline__ bool next(int i, Unit& u) const { return so.next(i, u); }
    __device__ __forceinline__ const char* a_ptr(const Unit& u) const { return A + (size_t)u.pm * BM * lda * 2; }
    __device__ __forceinline__ const char* b_ptr(const Unit& u) const { return Bt + (size_t)u.pn * BM * K * 2; }
    __device__ __forceinline__ void a_offs(const Unit&, const int (&rowA)[2], const unsigned (&colA)[2], unsigned (&o)[2][2]) const {
#pragma unroll
        for (int h = 0; h < 2; ++h)
#pragma unroll
            for (int i = 0; i < 2; ++i) o[h][i] = (unsigned)((h * HALF + rowA[i]) * lda) * 2u + colA[i];
    }
};
template <bool GATHER_> struct MoeSched {
    static constexpr bool GATHER = GATHER_;
    StaticOrder so; const char* A; const char* Bt; int lda, K; size_t estride; const int* tile_exp; const int* row_token;
    __device__ __forceinline__ bool next(int i, Unit& u) const { if (!so.next(i, u)) return false; u.e = tile_exp[u.pm]; return true; }
    __device__ __forceinline__ const char* a_ptr(const Unit& u) const { return GATHER ? A : A + (size_t)u.pm * BM * lda * 2; }
    __device__ __forceinline__ const char* b_ptr(const Unit& u) const { return Bt + (size_t)u.e * estride + (size_t)u.pn * BM * K * 2; }
    __device__ __forceinline__ void a_offs(const Unit& u, const int (&rowA)[2], const unsigned (&colA)[2], unsigned (&o)[2][2]) const {
#pragma unroll
        for (int h = 0; h < 2; ++h)
#pragma unroll
            for (int i = 0; i < 2; ++i) {
                if (GATHER) o[h][i] = (unsigned)row_token[u.pm * BM + h * HALF + rowA[i]] * (unsigned)(lda * 2) + colA[i];
                else o[h][i] = (unsigned)((h * HALF + rowA[i]) * lda) * 2u + colA[i];
            }
    }
};

typedef f32x4 Acc[2][2][4][2];

__device__ __forceinline__ u32x4 pack8(const f32x4 v0, const f32x4 v1) { u32x4 w; w.x = pk2(v0[0], v0[1]); w.y = pk2(v0[2], v0[3]); w.z = pk2(v1[0], v1[1]); w.w = pk2(v1[2], v1[3]); return w; }
__device__ __forceinline__ void unpack8(const u32x4 w, f32x4& v0, f32x4& v1) { v0 = (f32x4){bflo(w.x), bfhi(w.x), bflo(w.y), bfhi(w.y)}; v1 = (f32x4){bflo(w.z), bfhi(w.z), bflo(w.w), bfhi(w.w)}; }

__device__ __forceinline__ unsigned pk4_u8(const f32x4 v) {
    const float s = KF(255.f); unsigned p = 0;
    p = __builtin_amdgcn_cvt_pk_u8_f32(v[0] * s, 0, p); p = __builtin_amdgcn_cvt_pk_u8_f32(v[1] * s, 1, p); p = __builtin_amdgcn_cvt_pk_u8_f32(v[2] * s, 2, p); p = __builtin_amdgcn_cvt_pk_u8_f32(v[3] * s, 3, p); return p; }
__device__ __forceinline__ f32x4 unpk4_u8(unsigned w) { const float s = KF(1.f / 255.f); return (f32x4){(float)(w & 0xffu), (float)((w >> 8) & 0xffu), (float)((w >> 16) & 0xffu), (float)(w >> 24)} * s; }
__device__ __forceinline__ void gate8(const bf16* Gt, size_t ro, f32x4& g0, f32x4& g1) {
    if (GATE_U8) { const u32x2 w = *(const u32x2*)((const unsigned char*)Gt + ro); g0 = unpk4_u8(w.x); g1 = unpk4_u8(w.y); }
    else unpack8(*(const u32x4*)(Gt + ro), g0, g1);
}
template <bool P16_> __device__ __forceinline__ void gate16(const bf16* Gt, size_t ro, int bjstep, f32x4 (&g)[2][2]) {
    if (GATE_U8 && P16_) { const u32x4 w = *(const u32x4*)((const unsigned char*)Gt + ro); g[0][0] = unpk4_u8(w.x); g[0][1] = unpk4_u8(w.y); g[1][0] = unpk4_u8(w.z); g[1][1] = unpk4_u8(w.w); }
    else { gate8(Gt, ro, g[0][0], g[0][1]); gate8(Gt, ro + bjstep, g[1][0], g[1][1]); }
}
struct EpiProj {
    static constexpr bool PERM = true, P16 = (P16_MASK & 1) != 0; static constexpr int BJ = P16 ? 8 : HALF;
    struct Pre {}; __device__ __forceinline__ void pre(const Unit&, int, Pre&) const {}
    bf16 *Q, *Kb, *V, *U, *GA, *GP; const float* rope;
    __device__ __forceinline__ void operator()(const Acc& acc, const Unit& u, int wid, const Pre& PR) const {
        const int lane_ = lane_id(), wr = wid >> 2, wc = wid & 3, fr = lane_ & 15, fq = lane_ >> 4;
        const int pn = u.pn; bf16* base; int ld, ct, kind;
        if (pn < 3) { base = Q; ld = 768; ct = pn; kind = 1; }
        else if (pn < 6) { base = Kb; ld = 768; ct = pn - 3; kind = 1; }
        else if (pn < 9) { base = V; ld = 768; ct = pn - 6; kind = 0; }
        else if (pn < 11) { base = U; ld = 512; ct = pn - 9; kind = 0; }
        else if (pn < 15) { base = GA; ld = 1024; ct = pn - 11; kind = 2; }
        else { base = GP; ld = 1024; ct = pn - 15; kind = 2; }
        const int row0 = u.pm * BM + wr * 64 + fr, col0 = ct * BM + (P16 ? wc * 64 + 16 * fq : wc * 32 + 8 * fq);
        const bool do_rope = (kind == 1) && (P16 ? (fq == 0) : (((wc & 1) == 0) && (fq < 2)));
#pragma unroll
        for (int ai = 0; ai < 2; ++ai)
#pragma unroll
            for (int m = 0; m < 4; ++m) {
                const int row = row0 + ai * HALF + m * 16;
                f32x4 csb[2], snb[2];
#pragma unroll
                for (int bj = 0; bj < 2; ++bj) { csb[bj] = (f32x4){1.f, 1.f, 1.f, 1.f}; snb[bj] = (f32x4){0.f, 0.f, 0.f, 0.f};
                    if (do_rope) { const float* rp = rope + (size_t)(row & (S - 1)) * 16 + 4 * (P16 ? bj : fq); csb[bj] = *(const f32x4*)rp; snb[bj] = *(const f32x4*)(rp + 8); } }
                bf16* rowp = base + (size_t)row * ld + col0;
                unsigned wq[4];
#pragma unroll
                for (int bj = 0; bj < 2; ++bj) {
                    f32x4 v0 = acc[ai][bj][m][0], v1 = acc[ai][bj][m][1];
                    if (B_FP8) { const float zs = KF(1.f / (HSCALE * WSCALE)); v0 = v0 * zs; v1 = v1 * zs; }
                    if (kind == 1) { const f32x4 cs = csb[bj], sn = snb[bj]; const f32x4 n0 = v0 * cs - v1 * sn, n1 = v1 * cs + v0 * sn; v0 = n0; v1 = n1; }
                    if (kind == 2) {
#pragma unroll
                        for (int e = 0; e < 4; ++e) { v0[e] = fsigmoid(v0[e]); v1[e] = fsigmoid(v1[e]); }
                    }
                    if (GATE_U8 && kind == 2) { wq[2 * bj] = pk4_u8(v0); wq[2 * bj + 1] = pk4_u8(v1);
                        if (!P16) *(u32x2*)((unsigned char*)base + (size_t)row * ld + col0 + bj * BJ) = (u32x2){wq[2 * bj], wq[2 * bj + 1]}; }
                    else *(u32x4*)(rowp + bj * BJ) = pack8(v0, v1);
                }
                if (GATE_U8 && kind == 2 && P16) *(u32x4*)((unsigned char*)base + (size_t)row * ld + col0) = (u32x4){wq[0], wq[1], wq[2], wq[3]};
            }
    }
};
struct EpiGate {
    static constexpr bool PERM = true, P16 = (P16_MASK & 2) != 0; static constexpr int BJ = P16 ? 8 : HALF;
    struct Pre {}; __device__ __forceinline__ void pre(const Unit&, int, Pre&) const {}
    const bf16* Gt; bf16* O;
    __device__ __forceinline__ void operator()(const Acc& acc, const Unit& u, int wid, const Pre& PR) const {
        const int lane_ = lane_id(), wr = wid >> 2, wc = wid & 3, fr = lane_ & 15, fq = lane_ >> 4;
        const int row0 = u.pm * BM + wr * 64 + fr, col0 = u.pn * BM + (P16 ? wc * 64 + 16 * fq : wc * 32 + 8 * fq);
#pragma unroll
        for (int ai = 0; ai < 2; ++ai)
#pragma unroll
            for (int m = 0; m < 4; ++m) {
                const size_t ro = (size_t)(row0 + ai * HALF + m * 16) * D + col0;
                f32x4 gg[2][2]; gate16<P16>(Gt, ro, BJ, gg);
#pragma unroll
                for (int bj = 0; bj < 2; ++bj) *(u32x4*)(O + ro + bj * BJ) = pack8(acc[ai][bj][m][0] * gg[bj][0], acc[ai][bj][m][1] * gg[bj][1]);
                if (m & 1) __builtin_amdgcn_sched_barrier(0);
            }
    }
};
struct EpiGateAdd {
    static constexpr bool PERM = true, P16 = (P16_MASK & 4) != 0; static constexpr int BJ = P16 ? 8 : HALF;
    struct Pre {}; __device__ __forceinline__ void pre(const Unit&, int, Pre&) const {}
    const bf16* Gt; const bf16* P; bf16* O;
    __device__ __forceinline__ void operator()(const Acc& acc, const Unit& u, int wid, const Pre& PR) const {
        const int lane_ = lane_id(), wr = wid >> 2, wc = wid & 3, fr = lane_ & 15, fq = lane_ >> 4;
        const int row0 = u.pm * BM + wr * 64 + fr, col0 = u.pn * BM + (P16 ? wc * 64 + 16 * fq : wc * 32 + 8 * fq);
#pragma unroll
        for (int ai = 0; ai < 2; ++ai)
#pragma unroll
            for (int m = 0; m < 4; ++m) {
                const size_t ro = (size_t)(row0 + ai * HALF + m * 16) * D + col0;
                unsigned wq[4]; f32x4 gg[2][2]; gate16<P16>(Gt, ro, BJ, gg);
#pragma unroll
                for (int bj = 0; bj < 2; ++bj) {
                    f32x4 p0, p1; const f32x4 g0 = gg[bj][0], g1 = gg[bj][1]; unpack8(*(const u32x4*)(P + ro + bj * BJ), p0, p1);
                    const f32x4 o0 = p0 + acc[ai][bj][m][0] * g0, o1 = p1 + acc[ai][bj][m][1] * g1;
                    if (G_FP8) { wq[2 * bj] = pk4_fp8(o0[0] * HSCALE, o0[1] * HSCALE, o0[2] * HSCALE, o0[3] * HSCALE); wq[2 * bj + 1] = pk4_fp8(o1[0] * HSCALE, o1[1] * HSCALE, o1[2] * HSCALE, o1[3] * HSCALE);
                        if (!P16) *(u32x2*)((unsigned char*)O + ro + bj * BJ) = (u32x2){wq[2 * bj], wq[2 * bj + 1]}; }
                    else *(u32x4*)(O + ro + bj * BJ) = pack8(o0, o1);
                }
                if (G_FP8 && P16) *(u32x4*)((unsigned char*)O + ro) = (u32x4){wq[0], wq[1], wq[2], wq[3]};
                if (m & 1) __builtin_amdgcn_sched_barrier(0);
            }
    }
};
struct EpiXres {
    static constexpr bool PERM = true, P16 = (P16_MASK & 8) != 0; static constexpr int BJ = P16 ? 8 : HALF;
    struct Pre {}; __device__ __forceinline__ void pre(const Unit&, int, Pre&) const {}
    const void* xsrc; void* xout; const float* gate; bool src_f32;
    __device__ __forceinline__ void operator()(const Acc& acc, const Unit& u, int wid, const Pre& PR) const {
        const int lane_ = lane_id(), wr = wid >> 2, wc = wid & 3, fr = lane_ & 15, fq = lane_ >> 4;
        const int row0 = u.pm * BM + wr * 64 + fr, col0 = u.pn * BM + (P16 ? wc * 64 + 16 * fq : wc * 32 + 8 * fq);
        const float* gp = gate + (size_t)((u.pm * BM) / S) * 6 * D + col0;
        f32x4 gv[2][2];
#pragma unroll
        for (int bj = 0; bj < 2; ++bj) { gv[bj][0] = *(const f32x4*)(gp + bj * BJ); gv[bj][1] = *(const f32x4*)(gp + bj * BJ + 4);
            if (G_FP8) { const float zs = KF(1.f / (HSCALE * WSCALE)); gv[bj][0] = gv[bj][0] * zs; gv[bj][1] = gv[bj][1] * zs; } }
#pragma unroll
        for (int ai = 0; ai < 2; ++ai)
#pragma unroll
            for (int m = 0; m < 4; ++m) {
                const size_t ro = (size_t)(row0 + ai * HALF + m * 16) * D + col0;
#pragma unroll
                for (int bj = 0; bj < 2; ++bj) {
                    if (X_BF16 && P16 && !src_f32) {
                        f32x4 x0, x1; unpack8(*(const u32x4*)((const unsigned short*)xsrc + ro + bj * BJ), x0, x1);
                        *(u32x4*)((unsigned short*)xout + ro + bj * BJ) = pack8(x0 + gv[bj][0] * acc[ai][bj][m][0], x1 + gv[bj][1] * acc[ai][bj][m][1]);
                    } else {
                    const f32x4 x0 = xload4(xsrc, ro + bj * BJ, src_f32), x1 = xload4(xsrc, ro + bj * BJ + 4, src_f32);
                    xstore4(xout, ro + bj * BJ, x0 + gv[bj][0] * acc[ai][bj][m][0]);
                    xstore4(xout, ro + bj * BJ + 4, x1 + gv[bj][1] * acc[ai][bj][m][1]);
                    }
                }
                if (m & 1) __builtin_amdgcn_sched_barrier(0);
            }
    }
};
struct EpiSwiglu {
    static constexpr bool PERM = true, P16 = false;
    struct Pre {}; __device__ __forceinline__ void pre(const Unit&, int, Pre&) const {}
    bf16* ACT; const float* bgu; const int* tile_exp;
    __device__ __forceinline__ void operator()(const Acc& acc, const Unit& u, int wid, const Pre& PR) const {
        const int lane_ = lane_id(), wr = wid >> 2, wc = wid & 3, fr = lane_ & 15, fq = lane_ >> 4;
        const int row0 = u.pm * BM + wr * 64 + fr, col0 = u.pn * HALF + wc * 32 + 8 * fq;
        const float* bp = bgu + (size_t)u.e * 2048 + col0;
        const f32x4 bg0 = *(const f32x4*)bp, bg1 = *(const f32x4*)(bp + 4), bl0 = *(const f32x4*)(bp + 1024), bl1 = *(const f32x4*)(bp + 1028);
#pragma unroll
        for (int ai = 0; ai < 2; ++ai)
#pragma unroll
            for (int m = 0; m < 4; ++m) {
                constexpr float zs = MOE_FP8 ? 1.f / (HSCALE * WSCALE) : 1.f, osc = MOE_FP8 ? ASCALE : 1.f;
                f32x4 o0, o1;
#pragma unroll
                for (int hh = 0; hh < 2; ++hh) {
                    const f32x4 ga = acc[ai][0][m][hh] * zs + (hh ? bg1 : bg0), la = acc[ai][1][m][hh] * zs + (hh ? bl1 : bl0);
                    f32x4 o;
#pragma unroll
                    for (int q = 0; q < 4; q += 2) {
                        f32x2 a = {fminf(ga[q], 7.f), fminf(ga[q + 1], 7.f)};
                        f32x2 b = {__builtin_amdgcn_fmed3f(la[q], -7.f, 7.f), __builtin_amdgcn_fmed3f(la[q + 1], -7.f, 7.f)};
                        const f32x2 ea = a * (-1.702f * 1.4426950408889634f);
                        f32x2 d = {__builtin_amdgcn_exp2f(ea.x), __builtin_amdgcn_exp2f(ea.y)}; d = d + 1.f;
                        const f32x2 r = {__builtin_amdgcn_rcpf(d.x), __builtin_amdgcn_rcpf(d.y)};
                        const f32x2 t = a * r, u = b * osc + osc, w = t * u;
                        o[q] = w.x; o[q + 1] = w.y;
                    }
                    if (hh) o1 = o; else o0 = o;
                }
                if (MOE_FP8) { u32x2 w; w.x = pk4_fp8<false>(o0[0], o0[1], o0[2], o0[3]); w.y = pk4_fp8<false>(o1[0], o1[1], o1[2], o1[3]);
                    *(u32x2*)((unsigned char*)ACT + (size_t)(row0 + ai * HALF + m * 16) * D + col0) = w; }
                else *(u32x4*)(ACT + (size_t)(row0 + ai * HALF + m * 16) * D + col0) = pack8(o0, o1);
            }
    }
};
struct EpiDown {
    static constexpr bool PERM = true, P16 = (P16_MASK & 16) != 0; static constexpr int BJ = P16 ? 8 : HALF;
    struct Pre {}; __device__ __forceinline__ void pre(const Unit&, int, Pre&) const {}
    bf16* Y; const float* bdn; const int* tile_exp; const float* row_gate;
    __device__ __forceinline__ void operator()(const Acc& acc, const Unit& u, int wid, const Pre& PR) const {
        const int lane_ = lane_id(), wr = wid >> 2, wc = wid & 3, fr = lane_ & 15, fq = lane_ >> 4;
        const int row0 = u.pm * BM + wr * 64 + fr, col0 = u.pn * BM + (P16 ? wc * 64 + 16 * fq : wc * 32 + 8 * fq);
        const float* bp = bdn + (size_t)u.e * D + col0;
        f32x4 bv[2][2];
#pragma unroll
        for (int bj = 0; bj < 2; ++bj) { bv[bj][0] = *(const f32x4*)(bp + bj * BJ); bv[bj][1] = *(const f32x4*)(bp + bj * BJ + 4); }
        float gts[2][4];
#pragma unroll
        for (int ai = 0; ai < 2; ++ai)
#pragma unroll
            for (int m = 0; m < 4; ++m) gts[ai][m] = row_gate[row0 + ai * HALF + m * 16] * (Y_FP8 ? YSCALE : 1.f);
#pragma unroll
        for (int ai = 0; ai < 2; ++ai)
#pragma unroll
            for (int m = 0; m < 4; ++m) {
                const int row = row0 + ai * HALF + m * 16; const float gt = gts[ai][m]; constexpr float ys = MOE_FP8 ? 1.f / (ASCALE * WSCALE) : 1.f;
                unsigned wq[4];
#pragma unroll
                for (int bj = 0; bj < 2; ++bj) {
                    const f32x4 o0 = (acc[ai][bj][m][0] * ys + bv[bj][0]) * gt, o1 = (acc[ai][bj][m][1] * ys + bv[bj][1]) * gt;
                    if (Y_FP8) { wq[2 * bj] = pk4_fp8(o0[0], o0[1], o0[2], o0[3]); wq[2 * bj + 1] = pk4_fp8(o1[0], o1[1], o1[2], o1[3]);
                        if (!P16) *(u32x2*)((unsigned char*)Y + (size_t)row * D + col0 + bj * BJ) = (u32x2){wq[2 * bj], wq[2 * bj + 1]}; }
                    else *(u32x4*)(Y + (size_t)row * D + col0 + bj * BJ) = pack8(o0, o1); }
                if (Y_FP8 && P16) *(u32x4*)((unsigned char*)Y + (size_t)row * D + col0) = (u32x4){wq[0], wq[1], wq[2], wq[3]};
            }
    }
};

template <class Epi, class Sched, bool ALIGN_EPI, bool FP8 = false>
__device__ __forceinline__ void gemm_phase(LAS unsigned char* lds, const int K, const Sched& S, const Epi& E, const int wid) {
    const int lane = lane_id(), tid = wid * 64 + lane, wr = wid >> 2, wc = wid & 3, fr = lane & 15, fq = lane >> 4;
    typedef int i32x4_ __attribute__((ext_vector_type(4))); typedef int i32x8_ __attribute__((ext_vector_type(8)));
    const int nt = K / BK;
    int rowA[2]; unsigned colA[2], voffB[2];
#pragma unroll
    for (int i = 0; i < 2; ++i) { int R, C; stage_rc(tid * 16 + i * 8192, R, C); const int p32 = perm32(R & 31); const int Rb = Epi::P16 ? ((R >> 5) * 64 + 16 * (p32 >> 3) + (p32 & 7)) : (Epi::PERM ? ((R & ~31) + p32) : R);
        rowA[i] = R; colA[i] = (unsigned)C * 2u; voffB[i] = (unsigned)(Rb * K + C) * 2u; }
    const size_t kstep = (size_t)(BK * 2);
    const size_t hstepB = (size_t)(Epi::P16 ? 8 : HALF) * K * 2;
    const size_t hstepA = (size_t)HALF * S.lda * 2;
    unsigned voffA[2];
#pragma unroll
    for (int i = 0; i < 2; ++i) voffA[i] = (unsigned)(rowA[i] * S.lda) * 2u + colA[i];
    const size_t step64A = (size_t)64 * S.lda * 2, step64B = (size_t)(Epi::P16 ? 128 : 64) * K * 2;
    const unsigned ldsw = (unsigned)wid * 1024u;
    const int aoff = lds_byte(wr * 64 + fr, fq * 8), boff = lds_byte(wc * 32 + fr, fq * 8);
#define PG8_SA(b, h) (((b) * 2 + (h)) * HTB)
#define PG8_SB(b, h) ((4 + (b) * 2 + (h)) * HTB)
#define PG8_STAGE(bufoff, gbase, voff) do { _Pragma("unroll") for (int _i = 0; _i < 2; ++_i) \
        __builtin_amdgcn_global_load_lds((const GAS unsigned*)((gbase) + (voff)[_i]), (LAS unsigned*)(lds + (bufoff) + ldsw + _i * 8192), 16, 0, 0); } while (0)
#define PG8_STAGE1(bufoff, gbase, voff0, step64) do { _Pragma("unroll") for (int _i = 0; _i < 2; ++_i) \
        __builtin_amdgcn_global_load_lds((const GAS unsigned*)((gbase) + (size_t)_i * (step64) + (voff0)), (LAS unsigned*)(lds + (bufoff) + ldsw + _i * 8192), 16, 0, 0); } while (0)
#define PG8_STAGE_A(bufoff, gbase, h, OARR) do { if constexpr (Sched::GATHER) { PG8_STAGE(bufoff, gbase, OARR[h]); } else { PG8_STAGE1(bufoff, (gbase) + (h) * hstepA, voffA[0], step64A); } } while (0)
#define PG8_STAGE_B(bufoff, gbase) PG8_STAGE1(bufoff, gbase, voffB[0], step64B)
#define PG8_LD8(p) __builtin_shufflevector(*(const LAS i32x4_*)(p), *(const LAS i32x4_*)((p) + 1024), 0, 1, 2, 3, 4, 5, 6, 7)
#define PG8_LDA(dst, b, h) do { _Pragma("unroll") for (int m = 0; m < 4; ++m) dst[m] = PG8_LD8(lds + PG8_SA(b, h) + aoff + m * 2048); } while (0)
#define PG8_LDB(dst, b, h) do { _Pragma("unroll") for (int n = 0; n < 2; ++n) dst[n] = PG8_LD8(lds + PG8_SB(b, h) + boff + n * 2048); } while (0)
#define PG8_MMA(ai, bj, At, Bt) do { __builtin_amdgcn_s_setprio(1); _Pragma("unroll") for (int m = 0; m < 4; ++m) _Pragma("unroll") for (int n = 0; n < 2; ++n) { \
        if constexpr (FP8) asm volatile("v_mfma_f32_16x16x128_f8f6f4 %0, %1, %2, %0" : "+v"(acc[ai][bj][m][n]) : "v"(Bt[n]), "v"(At[m]));       \
        else { acc[ai][bj][m][n] = __builtin_amdgcn_mfma_f32_16x16x32_bf16(__builtin_bit_cast(bf16x8, __builtin_shufflevector(Bt[n], Bt[n], 0, 1, 2, 3)), __builtin_bit_cast(bf16x8, __builtin_shufflevector(At[m], At[m], 0, 1, 2, 3)), acc[ai][bj][m][n], 0, 0, 0); \
               acc[ai][bj][m][n] = __builtin_amdgcn_mfma_f32_16x16x32_bf16(__builtin_bit_cast(bf16x8, __builtin_shufflevector(Bt[n], Bt[n], 4, 5, 6, 7)), __builtin_bit_cast(bf16x8, __builtin_shufflevector(At[m], At[m], 4, 5, 6, 7)), acc[ai][bj][m][n], 0, 0, 0); } } \
        __builtin_amdgcn_s_setprio(0); } while (0)
#define PG8_WAIT_V(n) asm volatile("s_waitcnt vmcnt(" #n ")" ::: "memory")
#define PG8_WAIT_L(n) asm volatile("s_waitcnt lgkmcnt(" #n ")" ::: "memory")
#define PG8_BAR __builtin_amdgcn_s_barrier()
#define PG8_SCHED __builtin_amdgcn_sched_barrier(0)
#define PG8_PIN do { } while (0)
    Unit cur, nxt; int ui = 0;
    if (!S.next(0, cur)) return;
    typename Epi::Pre epre;
    Acc acc;
#pragma unroll
    for (int a = 0; a < 2; ++a)
#pragma unroll
        for (int b = 0; b < 2; ++b)
#pragma unroll
            for (int m = 0; m < 4; ++m)
#pragma unroll
                for (int n = 0; n < 2; ++n) acc[a][b][m][n] = (f32x4){0.f, 0.f, 0.f, 0.f};
    i32x8_ At[4], B0[2], B1[2];
    const int sc1 = 0x7F7F7F7F;
    unsigned oc[2][2], on[2][2];
    if constexpr (Sched::GATHER) S.a_offs(cur, rowA, colA, oc); else { oc[0][0] = oc[0][1] = oc[1][0] = oc[1][1] = 0u; }
#pragma unroll
    for (int h = 0; h < 2; ++h)
#pragma unroll
        for (int i = 0; i < 2; ++i) on[h][i] = oc[h][i];
    typedef const GAS char* gptr;
    gptr cA = (gptr)S.a_ptr(cur); gptr cB = (gptr)S.b_ptr(cur);
    PG8_STAGE_B(PG8_SB(0, 0), cB); PG8_STAGE_B(PG8_SB(0, 1), cB + hstepB); PG8_STAGE_A(PG8_SA(0, 0), cA, 0, oc); PG8_STAGE_A(PG8_SA(0, 1), cA, 1, oc);
    if (wr == 1) PG8_BAR;
    PG8_WAIT_V(2); PG8_BAR;
    PG8_STAGE_B(PG8_SB(1, 0), cB + kstep); PG8_STAGE_A(PG8_SA(1, 0), cA + kstep, 0, oc); PG8_STAGE_B(PG8_SB(1, 1), cB + hstepB + kstep);
    PG8_WAIT_V(6); PG8_BAR;
    for (;;) {
        const bool has_next = S.next(ui + 1, nxt);
        gptr nA = has_next ? (gptr)S.a_ptr(nxt) : cA; gptr nB = has_next ? (gptr)S.b_ptr(nxt) : cB;
        if (Sched::GATHER) { if (has_next) S.a_offs(nxt, rowA, colA, on); }
#pragma unroll 1
        for (int t = 0; t < nt; t += 2) {
            const bool last = (t == nt - 2);
            if (last) E.pre(cur, wid, epre);
            gptr a1 = cA + (size_t)(t + 1) * kstep;
            gptr a2 = last ? nA : cA + (size_t)(t + 2) * kstep; gptr b2 = last ? nB : cB + (size_t)(t + 2) * kstep;
            gptr a3 = a2 + kstep; gptr b3 = b2 + kstep;
            unsigned o2[2][2];
#pragma unroll
            for (int h = 0; h < 2; ++h)
#pragma unroll
                for (int i = 0; i < 2; ++i) o2[h][i] = (Sched::GATHER && last) ? on[h][i] : oc[h][i];
            PG8_LDB(B0, 0, 0); PG8_LDB(B1, 0, 1); PG8_SCHED; PG8_LDA(At, 0, 0); PG8_STAGE_A(PG8_SA(1, 1), a1, 1, oc);
            PG8_WAIT_V(8); PG8_WAIT_L(0); PG8_BAR; PG8_PIN; PG8_MMA(0, 0, At, B0); PG8_MMA(0, 1, At, B1); PG8_PIN; PG8_BAR; PG8_SCHED;
            PG8_LDA(At, 0, 1); PG8_STAGE_B(PG8_SB(0, 0), b2); PG8_STAGE_B(PG8_SB(0, 1), b2 + hstepB); PG8_STAGE_A(PG8_SA(0, 0), a2, 0, o2);
            PG8_WAIT_V(8); PG8_WAIT_L(0); PG8_BAR; PG8_PIN; PG8_MMA(1, 0, At, B0); PG8_MMA(1, 1, At, B1); PG8_PIN; PG8_BAR; PG8_SCHED;
            PG8_LDB(B0, 1, 0); PG8_LDB(B1, 1, 1); PG8_SCHED; PG8_LDA(At, 1, 0); PG8_STAGE_A(PG8_SA(0, 1), a2, 1, o2);
            PG8_WAIT_V(8); PG8_WAIT_L(0); PG8_BAR; PG8_PIN; PG8_MMA(0, 0, At, B0); PG8_MMA(0, 1, At, B1); PG8_PIN; PG8_BAR; PG8_SCHED;
            PG8_LDA(At, 1, 1); PG8_STAGE_B(PG8_SB(1, 0), b3); PG8_STAGE_B(PG8_SB(1, 1), b3 + hstepB); PG8_STAGE_A(PG8_SA(1, 0), a3, 0, o2);
            PG8_WAIT_V(8); PG8_WAIT_L(0); PG8_BAR; PG8_PIN; PG8_MMA(1, 0, At, B0); PG8_MMA(1, 1, At, B1); PG8_PIN; PG8_BAR; PG8_SCHED;
        }
        if constexpr (ALIGN_EPI) { if (wr == 0) PG8_BAR; }
        if constexpr (FP8) asm volatile("s_nop 15\n\ts_nop 15" ::: "memory");
        E(acc, cur, wid, epre);
        if (!has_next) break;
#pragma unroll
        for (int a = 0; a < 2; ++a)
#pragma unroll
            for (int b = 0; b < 2; ++b)
#pragma unroll
                for (int m = 0; m < 4; ++m)
#pragma unroll
                    for (int n = 0; n < 2; ++n) acc[a][b][m][n] = (f32x4){0.f, 0.f, 0.f, 0.f};
        cur = nxt; cA = nA; cB = nB; ++ui;
#pragma unroll
        for (int h = 0; h < 2; ++h)
#pragma unroll
            for (int i = 0; i < 2; ++i) oc[h][i] = on[h][i];
        if constexpr (ALIGN_EPI) { if (wr == 1) PG8_BAR; }
    }
    PG8_WAIT_V(0);
    if constexpr (!ALIGN_EPI) { if (wr == 0) PG8_BAR; }
    PG8_BAR;
#undef PG8_SA
#undef PG8_SB
#undef PG8_STAGE
#undef PG8_STAGE_A
#undef PG8_STAGE_B
#undef PG8_STAGE1
#undef PG8_LD8
#undef PG8_LDA
#undef PG8_LDB
#undef PG8_MMA
#undef PG8_WAIT_V
#undef PG8_WAIT_L
#undef PG8_BAR
#undef PG8_SCHED
#undef PG8_PIN
}

constexpr size_t MiB = 1u << 20;
constexpr size_t al(size_t x) { return (x + 4095) & ~(size_t)4095; }
constexpr size_t WS_CTL = 0, CTL_WORDS_BYTES = 2 * MiB;
constexpr size_t WS_MOD = WS_CTL + CTL_WORDS_BYTES;
constexpr size_t MOD_BYTES = (size_t)DEPTH * NB * 6 * D * 4;
constexpr size_t ZERO_BYTES = al(CTL_WORDS_BYTES + MOD_BYTES);
constexpr size_t WS_ROPE = ZERO_BYTES;
constexpr size_t WS_RWT = al(WS_ROPE + (size_t)S * 16 * 4);
constexpr size_t WS_WIN = al(WS_RWT + (size_t)DEPTH * NE * D * 4);
constexpr size_t WS_WA = al(WS_WIN + (size_t)DEPTH * IN_COLS * D * 2);
constexpr size_t WS_WP = al(WS_WA + (size_t)DEPTH * D * 256 * 2);
constexpr size_t WS_WOUT = al(WS_WP + (size_t)DEPTH * D * 512 * 2);
constexpr size_t WS_WGU = al(WS_WOUT + (size_t)DEPTH * D * D * 2);
constexpr size_t WS_WDN = al(WS_WGU + (size_t)DEPTH * NE * 2048 * D * EB);
constexpr size_t WS_H8 = al(WS_WDN + (size_t)DEPTH * NE * D * D * EB);
constexpr size_t WS_X = al(WS_H8 + (size_t)T * D);
constexpr size_t WS_H = al(WS_X + (size_t)T * D * 4);
constexpr size_t WS_Q = al(WS_H + (size_t)T * D * 2);
constexpr size_t WS_K = al(WS_Q + (size_t)T * 768 * 2);
constexpr size_t WS_V = al(WS_K + (size_t)T * 768 * 2);
constexpr size_t WS_U = al(WS_V + (size_t)T * 768 * 2);
constexpr size_t WS_GA = al(WS_U + (size_t)T * 512 * 2);
constexpr size_t WS_GP = al(WS_GA + (size_t)T * D * 2);
constexpr size_t WS_OG = al(WS_GP + (size_t)T * D * 2);
constexpr size_t WS_LSE = al(WS_OG + (size_t)T * 768 * 2);
constexpr size_t WS_AD = al(WS_LSE + (size_t)T * 12 * 4);
constexpr size_t WS_MA = al(WS_AD + (size_t)T * 768 * 2);
constexpr size_t WS_MG = al(WS_MA + (size_t)T * D * 2);
constexpr size_t WS_TOPE = al(WS_MG + (size_t)T * D * 2);
constexpr size_t WS_TOPG = al(WS_TOPE + (size_t)NASSIGN * 4);
constexpr size_t WS_LRANK = al(WS_TOPG + (size_t)NASSIGN * 4);
constexpr size_t WS_HIST = al(WS_LRANK + (size_t)NASSIGN * 4);
constexpr size_t WS_ROWTOK = al(WS_HIST + (size_t)GRID * NE * 4);
constexpr size_t WS_ROWGATE = al(WS_ROWTOK + (size_t)NROWS_MAX * 4);
constexpr size_t WS_TOKROW = al(WS_ROWGATE + (size_t)NROWS_MAX * 4);
constexpr size_t WS_TILEEXP = al(WS_TOKROW + (size_t)NASSIGN * 4);
constexpr size_t WS_ACT = al(WS_TILEEXP + (size_t)(NROWS_MAX / RPAD + 16) * 4);
constexpr size_t WS_Y = al(WS_ACT + (size_t)NROWS_MAX * D * 2);
constexpr size_t WS_END = al(WS_Y + (size_t)NROWS_MAX * D * 2);
constexpr int NRT_SLOT = NROWS_MAX / RPAD + 8;

constexpr int CW_BAR = 4096, BAR_REGION_WORDS = 4096, MAX_LAUNCHES = 100;
static_assert((CW_BAR + MAX_LAUNCHES * BAR_REGION_WORDS) * 4 <= (int)CTL_WORDS_BYTES, "ctl");

constexpr int RING_BYTES = 131072, MISC_OFF = RING_BYTES, LDS_BYTES = 147456;

#define XB_TMO      128
#define XB_XCNT(j)  (256  + 64 * (j))
#define XB_XSUB(j)  (1280 + 64 * (j))
#define XB_XGEN(j)  (2304 + 64 * (j))
#define XB_TOP      3328
#define XB_TOPGEN   3392
#define XCD_BAR_WORDS 3456
#define XB_SPIN_CAP (1u << 18)
__device__ __forceinline__ unsigned xb_ld(unsigned* p)              { return __hip_atomic_load(p, __ATOMIC_RELAXED, __HIP_MEMORY_SCOPE_AGENT); }
__device__ __forceinline__ unsigned xb_add(unsigned* p, unsigned v) { return __hip_atomic_fetch_add(p, v, __ATOMIC_RELAXED, __HIP_MEMORY_SCOPE_AGENT); }
__device__ __forceinline__ unsigned xb_xcc_id() { return (unsigned)__builtin_amdgcn_s_getreg((3 << 11) | 20) & 0xFu; }
#define XB_SPIN(cond, bar) do { unsigned _sp = 0; while (cond) { __builtin_amdgcn_s_sleep(1); \
    if ((++_sp & 255u) == 0u) { if (xb_ld(&(bar)[XB_TMO])) break; if (_sp > XB_SPIN_CAP) { atomicAdd(&(bar)[XB_TMO], 1u); break; } } } } while (0)
struct XcdBarrier { unsigned* bar; unsigned x; volatile LAS unsigned* st; };
__device__ __forceinline__ XcdBarrier xcd_barrier_post(unsigned* bar, volatile LAS unsigned* st, const bool leader  ) {
    XcdBarrier b; b.bar = bar; b.x = xb_xcc_id(); b.st = st;
    if (leader) (void)xb_add(&bar[XB_XCNT(b.x)], 1u);
    return b;
}
__device__ __forceinline__ void xcd_barrier_complete(unsigned* bar, unsigned x, unsigned& nloc, unsigned& nx) {
    const unsigned G = gridDim.x * gridDim.y * gridDim.z;
    unsigned sum, cnt, mine, sp = 0u;
    for (;;) {
        sum = 0u; cnt = 0u; mine = 0u;
#pragma unroll
        for (unsigned j = 0; j < 16; ++j) { const unsigned c = xb_ld(&bar[XB_XCNT(j)]); sum += c; cnt += (c > 0u) ? 1u : 0u; mine = (j == x) ? c : mine; }
        if (sum == G) break;
        __builtin_amdgcn_s_sleep(1);
        if ((++sp & 255u) == 0u) { if (xb_ld(&bar[XB_TMO])) break; if (sp > XB_SPIN_CAP) { atomicAdd(&bar[XB_TMO], 1u); break; } }
    }
    nloc = mine > 0u ? mine : 1u; nx = cnt > 0u ? cnt : 1u;
}
__device__ __forceinline__ void xcd_barrier(const XcdBarrier& b, const bool leader  ) {
    asm volatile("s_waitcnt vmcnt(0)" ::: "memory");
    __syncthreads();
    if (leader) {
        unsigned* bar = b.bar;
        __builtin_amdgcn_s_waitcnt(0);
        unsigned nloc = b.st[0], nx = b.st[1];
        if (nloc == 0u) { xcd_barrier_complete(bar, b.x, nloc, nx); b.st[0] = nloc; b.st[1] = nx; }
        const unsigned old = xb_add(&bar[XB_XSUB(b.x)], 1u);
        const unsigned gen = old / nloc;
        if (old + 1u == (gen + 1u) * nloc) {
            __builtin_amdgcn_fence(__ATOMIC_RELEASE, "agent");
            asm volatile("s_waitcnt vmcnt(0)" ::: "memory");
            const unsigned og = xb_add(&bar[XB_TOP], 1u);
            const unsigned tg = og / nx;
            if (og + 1u == (tg + 1u) * nx) xb_add(&bar[XB_TOPGEN], 1u);
            else XB_SPIN(xb_ld(&bar[XB_TOPGEN]) == tg, bar);
            __builtin_amdgcn_fence(__ATOMIC_ACQUIRE, "agent");
            xb_add(&bar[XB_XGEN(b.x)], 1u);
            asm volatile("s_waitcnt vmcnt(0)" ::: "memory");
        } else {
            XB_SPIN(xb_ld(&bar[XB_XGEN(b.x)]) == gen, bar);
            __builtin_amdgcn_fence(__ATOMIC_ACQUIRE, "agent");
            asm volatile("s_waitcnt vmcnt(0)" ::: "memory");
        }
    }
    __syncthreads();
}

struct Args {
    const float* in[19]; float* out; unsigned char* ws;
    int ph_lo, ph_hi, li, flags;
};
struct Frame {
    LAS unsigned char* lds; int wave, G, blk;
    unsigned char* ws;
    const float *x_in, *c, *ada_w, *ada_b, *norm1_g, *w_in, *pool_w, *pool_scale, *w_ab, *w_pb, *w_out, *norm2_g, *router_w, *router_b, *w_gu, *b_gu, *w_down, *b_down, *final_g;
    float* out;
};
#define WSP(type, off) ((type*)(F.ws + (off)))
typedef __attribute__((address_space(4))) const Args CArgs;
__device__ __forceinline__ CArgs* kargs() { CArgs* p = (CArgs*)__builtin_amdgcn_kernarg_segment_ptr(); asm volatile("" : "+s"(p)); return p; }
__device__ __forceinline__ Frame make_frame(CArgs* a, LAS unsigned char* lds, int wave) {
    Frame F; F.lds = lds; F.wave = wave; F.G = gridDim.x; F.blk = blockIdx.x; F.ws = a->ws;
    F.x_in = a->in[0]; F.c = a->in[1]; F.ada_w = a->in[2]; F.ada_b = a->in[3]; F.norm1_g = a->in[4]; F.w_in = a->in[5]; F.pool_w = a->in[6]; F.pool_scale = a->in[7];
    F.w_ab = a->in[8]; F.w_pb = a->in[9]; F.w_out = a->in[10]; F.norm2_g = a->in[11]; F.router_w = a->in[12]; F.router_b = a->in[13]; F.w_gu = a->in[14]; F.b_gu = a->in[15];
    F.w_down = a->in[16]; F.b_down = a->in[17]; F.final_g = a->in[18]; F.out = a->out;
    return F;
}

template <class DestFn>
__device__ __forceinline__ void transpose_item(const float* W, int K, int N, bf16* WT, const DestFn& dest, LAS float* scr, int item, int lane) {
    const int nblk = N / 32, kb = item / nblk, nb = item % nblk, k0 = 64 * kb, n0 = 32 * nb;
    float wv[32];
#pragma unroll
    for (int i = 0; i < 32; ++i) wv[i] = __builtin_nontemporal_load(W + (size_t)(k0 + 2 * i + (lane >> 5)) * N + n0 + (lane & 31));
#pragma unroll
    for (int i = 0; i < 32; ++i) scr[(2 * i + (lane >> 5)) * 33 + (lane & 31)] = wv[i];
    asm volatile("s_waitcnt lgkmcnt(0)" ::: "memory");
    const int c = lane & 7;
#pragma unroll
    for (int j = 0; j < 4; ++j) { const int n = (lane >> 3) + 8 * j; const LAS float* s = scr + (8 * c) * 33 + n;
        u32x4 o; o.x = pk2(s[0 * 33], s[1 * 33]); o.y = pk2(s[2 * 33], s[3 * 33]); o.z = pk2(s[4 * 33], s[5 * 33]); o.w = pk2(s[6 * 33], s[7 * 33]);
        *(u32x4*)(WT + (size_t)dest(n0 + n) * K + k0 + 8 * c) = o; }
    asm volatile("s_waitcnt lgkmcnt(0)" ::: "memory");
}
__device__ __forceinline__ void t8_load(const float* W, int N, int item, int lane, float (&wv)[32]) {
    const int nblk = N / 32, kb = item / nblk, nb = item % nblk, k0 = 64 * kb, n0 = 32 * nb;
#pragma unroll
    for (int i = 0; i < 32; ++i) wv[i] = __builtin_nontemporal_load(W + (size_t)(k0 + 2 * i + (lane >> 5)) * N + n0 + (lane & 31));
}
template <class DestFn>
__device__ __forceinline__ void t8_store(const float (&wv)[32], int K, int N, unsigned char* WT, const DestFn& dest, LAS float* scr, int item, int lane, float scale) {
    const int nblk = N / 32, kb = item / nblk, nb = item % nblk, k0 = 64 * kb, n0 = 32 * nb;
#pragma unroll
    for (int i = 0; i < 32; ++i) scr[(2 * i + (lane >> 5)) * 33 + (lane & 31)] = wv[i];
    asm volatile("s_waitcnt lgkmcnt(0)" ::: "memory");
    const int c = lane & 7;
#pragma unroll
    for (int j = 0; j < 4; ++j) { const int n = (lane >> 3) + 8 * j; const LAS float* sp = scr + (8 * c) * 33 + n;
        u32x2 o; o.x = pk4_fp8(sp[0 * 33] * scale, sp[1 * 33] * scale, sp[2 * 33] * scale, sp[3 * 33] * scale); o.y = pk4_fp8(sp[4 * 33] * scale, sp[5 * 33] * scale, sp[6 * 33] * scale, sp[7 * 33] * scale);
        *(u32x2*)(WT + (size_t)dest(n0 + n) * K + k0 + 8 * c) = o; }
    asm volatile("s_waitcnt lgkmcnt(0)" ::: "memory");
}
constexpr int T8B_PITCH = 260;
__device__ __forceinline__ void t8b_load(const float* W, int N, int k0, int n0, int wave, int lane, f32x4 (&v)[4][4]) {
#pragma unroll
    for (int j = 0; j < 4; ++j)
#pragma unroll
        for (int r = 0; r < 4; ++r) v[j][r] = __builtin_nontemporal_load((const f32x4*)(W + (size_t)(k0 + 16 * wave + 4 * j + r) * N + n0 + 4 * lane));
}
template <class DestFn>
__device__ __forceinline__ void t8b_store(const f32x4 (&v)[4][4], int K, unsigned char* WT, const DestFn& dest, int k0, int n0, LAS unsigned* L, int wave, int lane, float scale) {
#pragma unroll
    for (int j = 0; j < 4; ++j) {
        u32x4 w;
#pragma unroll
        for (int c = 0; c < 4; ++c) w[c] = pk4_fp8(v[j][0][c] * scale, v[j][1][c] * scale, v[j][2][c] * scale, v[j][3][c] * scale);
        *(LAS u32x4*)(L + (wave * 4 + j) * T8B_PITCH + 4 * lane) = w;
    }
    __syncthreads();
    const int tid = wave * 64 + lane;
#pragma unroll
    for (int q4 = 0; q4 < 4; ++q4) {
        const int p = tid + NTHREADS * q4, n = p >> 3, g = p & 7;
        u32x4 o;
#pragma unroll
        for (int q = 0; q < 4; ++q) o[q] = L[(4 * g + q) * T8B_PITCH + n];
        *(u32x4*)(WT + (size_t)dest(n0 + n) * K + k0 + 16 * g) = o;
    }
    __syncthreads();
}
struct DestId { __device__ __forceinline__ int operator()(int n) const { return n; } };
struct DestWin {
    __device__ __forceinline__ int operator()(int n) const { if (n >= 1536 || (n & 63) >= 16) return n; const int d = n & 15; return (n & ~15) | (d & 3) | (((d >> 3) & 1) << 2) | (((d >> 2) & 1) << 3); } };
struct DestGu {
    __device__ __forceinline__ int operator()(int n) const { const int j = n & 1023; return (j >> 7) * 256 + (n >> 10) * 128 + (j & 127); } };

__device__ __forceinline__ void prologue_small(const Frame& F, const int MASK = 31) {
    const int gw = F.blk * NWAVES + F.wave, NGW = F.G * NWAVES, lane = lane_id(), tid_p = F.wave * 64 + lane;
    if (MASK & 1) {
        LAS float* cact = (LAS float*)F.lds;
        LAS f32x4* part = (LAS f32x4*)(F.lds + 65536);
        float* mod = WSP(float, WS_MOD);
        constexpr int NITEM = DEPTH * 24;
        if (F.blk < NITEM) {
            for (int i = tid_p; i < NB * D; i += NTHREADS) { const int bb = i / D, k = i % D; const float v = F.c[i]; cact[k * NB + bb] = v / (1.f + __expf(-v)); }
            __syncthreads();
        }
        for (int it = F.blk; it < NITEM; it += F.G) {
            const int kc = F.wave, jb = it % 24, l = it / 24, j = jb * 256 + 4 * lane;
            f32x4 acc[NB];
#pragma unroll
            for (int bb = 0; bb < NB; ++bb) acc[bb] = (f32x4){0.f, 0.f, 0.f, 0.f};
            const float* wp = F.ada_w + ((size_t)l * D + kc * 128) * (6 * D) + j;
#pragma unroll 1
            for (int k0 = 0; k0 < 128; k0 += 16) {
                f32x4 wv[16];
#pragma unroll
                for (int u = 0; u < 16; ++u) wv[u] = __builtin_nontemporal_load((const f32x4*)(wp + (size_t)(k0 + u) * (6 * D)));
#pragma unroll
                for (int u = 0; u < 16; ++u) {
                    const LAS f32x4* cp = (const LAS f32x4*)(cact + (kc * 128 + k0 + u) * NB);
#pragma unroll
                    for (int q = 0; q < 4; ++q) { const f32x4 cv = cp[q]; acc[4 * q] += wv[u] * cv[0]; acc[4 * q + 1] += wv[u] * cv[1]; acc[4 * q + 2] += wv[u] * cv[2]; acc[4 * q + 3] += wv[u] * cv[3]; }
                }
            }
#pragma unroll
            for (int rnd = 0; rnd < 2; ++rnd) {
#pragma unroll
                for (int bb = 0; bb < 8; ++bb) part[(kc * 8 + bb) * 64 + lane] = acc[rnd * 8 + bb];
                __syncthreads();
                const int bo = rnd * 8 + F.wave;
                f32x4 sum = *(const f32x4*)(F.ada_b + l * 6 * D + j);
#pragma unroll
                for (int w = 0; w < NWAVES; ++w) sum += part[(w * 8 + F.wave) * 64 + lane];
                *(f32x4*)(mod + ((size_t)l * NB + bo) * (6 * D) + j) = sum;
                __syncthreads();
            }
        }
        __syncthreads();
    }
    if (MASK & 2) {
        float* rope = WSP(float, WS_ROPE);
        for (int i = gw * 64 + lane; i < S * 8; i += NGW * 64) {
            const int s = i >> 3, j = i & 7;
            const float invs[8] = {1.0f, 0.1939227432012558f, 0.03760603070259094f, 0.007292664609849453f, 0.0014142135623842478f, 0.00027424818836152554f, 5.318296098266728e-05f, 1.0313386155758053e-05f};
            float inv = invs[0];
#pragma unroll
            for (int q = 1; q < 8; ++q) inv = (j == q) ? invs[q] : inv;
            const float ang = (float)s * inv;
            rope[s * 16 + j] = cosf(ang); rope[s * 16 + 8 + j] = sinf(ang);
        }
    }
    if (MASK & 4) {
        float* rwt = WSP(float, WS_RWT);
        for (int i = gw * 64 + lane; i < DEPTH * NE * D; i += NGW * 64) { const int k = i & (D - 1), e = (i >> 10) & (NE - 1), l = i >> 15; rwt[i] = F.router_w[((size_t)l * D + k) * NE + e]; }
    }
    if (MASK & 8) {
        bf16* WP = WSP(bf16, WS_WP);
        LAS float* pwl = (LAS float*)F.lds;
        constexpr int NITEM = DEPTH * 4 * 16;
        for (int it = F.blk; it < NITEM; it += F.G) {
            const int nbk = it & 15, g = (it >> 4) & 3, l = it >> 6, n = nbk * 64 + lane;
            const float* pw = F.pool_w + ((size_t)l * 4 + g) * 128 * 128;
            const float* ps = F.pool_scale + l * 512 + g * 128;
            __syncthreads();
            for (int i = tid_p; i < 128 * 128; i += NTHREADS) { const int c = i >> 7, d = i & 127; pwl[d * 128 + c] = pw[i] * ps[d]; }
            __syncthreads();
            float acc[16];
#pragma unroll
            for (int q = 0; q < 16; ++q) acc[q] = 0.f;
            const float* wb = F.w_pb + ((size_t)l * 512 + g * 128) * D + n;
#pragma unroll 1
            for (int d0 = 0; d0 < 128; d0 += 32) {
                float wv[32];
#pragma unroll
                for (int u = 0; u < 32; ++u) wv[u] = wb[(size_t)(d0 + u) * D];
#pragma unroll
                for (int u = 0; u < 32; ++u) {
                    const LAS f32x4* cp = (const LAS f32x4*)(pwl + (d0 + u) * 128 + 16 * F.wave);
#pragma unroll
                    for (int q = 0; q < 4; ++q) { const f32x4 cv = cp[q]; acc[4 * q] += cv[0] * wv[u]; acc[4 * q + 1] += cv[1] * wv[u]; acc[4 * q + 2] += cv[2] * wv[u]; acc[4 * q + 3] += cv[3] * wv[u]; }
                }
            }
            u32x4 o0, o1;
            o0.x = pk2(acc[0], acc[1]); o0.y = pk2(acc[2], acc[3]); o0.z = pk2(acc[4], acc[5]); o0.w = pk2(acc[6], acc[7]);
            o1.x = pk2(acc[8], acc[9]); o1.y = pk2(acc[10], acc[11]); o1.z = pk2(acc[12], acc[13]); o1.w = pk2(acc[14], acc[15]);
            bf16* op = WP + ((size_t)l * D + n) * 512 + g * 128 + 16 * F.wave;
            *(u32x4*)op = o0; *(u32x4*)(op + 8) = o1;
        }
        __syncthreads();
    }
    if (MASK & 16) {
        LAS float* scr = (LAS float*)(F.lds + F.wave * 16384);
        { constexpr int PER = (D / 64) * (IN_COLS / 32); const DestWin dw;
          for (int it = gw; it < DEPTH * PER; it += NGW) { const int l = it / PER;
              if (B_FP8) { float wv[32]; t8_load(F.w_in + (size_t)l * D * IN_COLS, IN_COLS, it % PER, lane, wv); t8_store(wv, D, IN_COLS, WSP(unsigned char, WS_WIN) + (size_t)l * IN_COLS * D, dw, scr, it % PER, lane, WSCALE); }
              else transpose_item(F.w_in + (size_t)l * D * IN_COLS, D, IN_COLS, WSP(bf16, WS_WIN) + (size_t)l * IN_COLS * D, dw, scr, it % PER, lane); } }
        { constexpr int PER = (256 / 64) * (D / 32); const DestId di;
          for (int it = gw; it < DEPTH * PER; it += NGW) { const int l = it / PER; transpose_item(F.w_ab + (size_t)l * 256 * D, 256, D, WSP(bf16, WS_WA) + (size_t)l * D * 256, di, scr, it % PER, lane); } }
        { constexpr int PER = (D / 64) * (D / 32); const DestId di;
          for (int it = gw; it < DEPTH * PER; it += NGW) { const int l = it / PER;
              if (G_FP8) { float wv[32]; t8_load(F.w_out + (size_t)l * D * D, D, it % PER, lane, wv); t8_store(wv, D, D, WSP(unsigned char, WS_WOUT) + (size_t)l * D * D, di, scr, it % PER, lane, WSCALE); }
              else transpose_item(F.w_out + (size_t)l * D * D, D, D, WSP(bf16, WS_WOUT) + (size_t)l * D * D, di, scr, it % PER, lane); } }
    }
}
constexpr int CT_PER_GU = (D / 128) * (2048 / 256), CT_PER_DN = (D / 128) * (D / 256), CT_N_GU = DEPTH * NE * CT_PER_GU, CT_NIT = CT_N_GU + DEPTH * NE * CT_PER_DN;
__device__ __forceinline__ void convert_tile(const Frame& F, int it, int lane) {
    const DestGu dg; const DestId di; LAS unsigned* L = (LAS unsigned*)F.lds; f32x4 v[4][4];
    if (it < CT_N_GU) { const int le = it / CT_PER_GU, r = it % CT_PER_GU; t8b_load(F.w_gu + (size_t)le * D * 2048, 2048, 128 * (r >> 3), 256 * (r & 7), F.wave, lane, v);
        t8b_store(v, D, WSP(unsigned char, WS_WGU) + (size_t)le * 2048 * D, dg, 128 * (r >> 3), 256 * (r & 7), L, F.wave, lane, WSCALE); }
    else { const int q = it - CT_N_GU, le = q / CT_PER_DN, r = q % CT_PER_DN; t8b_load(F.w_down + (size_t)le * D * D, D, 128 * (r >> 2), 256 * (r & 3), F.wave, lane, v);
        t8b_store(v, D, WSP(unsigned char, WS_WDN) + (size_t)le * D * D, di, 128 * (r >> 2), 256 * (r & 3), L, F.wave, lane, WSCALE); }
}
constexpr int CT_PER_LAYER = NE * (CT_PER_GU + CT_PER_DN);
constexpr int CW_CQ = 3072;
__device__ __forceinline__ int ct_global(int t, int j) { return j < NE * CT_PER_GU ? t * NE * CT_PER_GU + j : CT_N_GU + t * NE * CT_PER_DN + (j - NE * CT_PER_GU); }
__device__ __forceinline__ int ct_dequeue(const Frame& F, int t, int lane) {
    LAS int* slot = (LAS int*)(F.lds + MISC_OFF + 512);
    if (F.wave == 0 && lane == 0) *slot = (int)__hip_atomic_fetch_add((unsigned*)(F.ws + WS_CTL) + CW_CQ + 64 * t, 1u, __ATOMIC_RELAXED, __HIP_MEMORY_SCOPE_AGENT);
    __syncthreads();
    const int j = *slot;
    __syncthreads();
    return j;
}
__device__ __forceinline__ void tail_convert(const Frame& F, int t, int n) {
    const int lane = lane_id();
    for (int q = 0; q < n && t < DEPTH; ) {
        const int j = ct_dequeue(F, t, lane);
        if (j >= CT_PER_LAYER) { ++t; continue; }
        convert_tile(F, ct_global(t, j), lane); ++q;
    }
}
__device__ __forceinline__ void drain_convert(const Frame& F, int t) {
    const int lane = lane_id();
    for (;;) { const int j = ct_dequeue(F, t, lane); if (j >= CT_PER_LAYER) break; convert_tile(F, ct_global(t, j), lane); }
}
__device__ __forceinline__ void drain_static(const Frame& F, int t) {
    const int lane = lane_id();
    int h0 = (int)__hip_atomic_load((unsigned*)(F.ws + WS_CTL) + CW_CQ + 64 * t, __ATOMIC_RELAXED, __HIP_MEMORY_SCOPE_AGENT); h0 = __builtin_amdgcn_readfirstlane(h0);
    const DestGu dg; const DestId di; LAS unsigned* L = (LAS unsigned*)F.lds;
    f32x4 cur[4][4], nxt[4][4];
    auto ld = [&](int j, f32x4 (&v)[4][4]) { const int it = ct_global(t, j);
        if (it < CT_N_GU) { const int le = it / CT_PER_GU, r = it % CT_PER_GU; t8b_load(F.w_gu + (size_t)le * D * 2048, 2048, 128 * (r >> 3), 256 * (r & 7), F.wave, lane, v); }
        else { const int q = it - CT_N_GU, le = q / CT_PER_DN, r = q % CT_PER_DN; t8b_load(F.w_down + (size_t)le * D * D, D, 128 * (r >> 2), 256 * (r & 3), F.wave, lane, v); } };
    auto st = [&](int j, const f32x4 (&v)[4][4]) { const int it = ct_global(t, j);
        if (it < CT_N_GU) { const int le = it / CT_PER_GU, r = it % CT_PER_GU; t8b_store(v, D, WSP(unsigned char, WS_WGU) + (size_t)le * 2048 * D, dg, 128 * (r >> 3), 256 * (r & 7), L, F.wave, lane, WSCALE); }
        else { const int q = it - CT_N_GU, le = q / CT_PER_DN, r = q % CT_PER_DN; t8b_store(v, D, WSP(unsigned char, WS_WDN) + (size_t)le * D * D, di, 128 * (r >> 2), 256 * (r & 3), L, F.wave, lane, WSCALE); } };
    __syncthreads();
    int j = h0 + F.blk;
    if (j < CT_PER_LAYER) ld(j, cur);
#pragma unroll 1
    for (; j < CT_PER_LAYER; j += F.G) {
        const int jn = j + F.G;
        if (jn < CT_PER_LAYER) ld(jn, nxt);
        st(j, cur);
#pragma unroll
        for (int a = 0; a < 4; ++a)
#pragma unroll
            for (int r = 0; r < 4; ++r) cur[a][r] = nxt[a][r];
    }
}
__device__ __forceinline__ int spare_units(int nwg, int G, int c) { const int mx = (nwg + G - 1) / G, mine = c < nwg ? (nwg - c + G - 1) / G : 0; return mx - mine; }
__device__ __forceinline__ void prologue_moe(const Frame& F) {
    const int gw = F.blk * NWAVES + F.wave, NGW = F.G * NWAVES, lane = lane_id();
    {
        LAS float* scr = (LAS float*)(F.lds + F.wave * 16384);
        if (MOE_FP8) {
            __syncthreads();
            constexpr int PER_GU = (D / 128) * (2048 / 256), PER_DN = (D / 128) * (D / 256), N_GU = DEPTH * NE * PER_GU, NIT = CT_PER_LAYER;
            const DestGu dg; const DestId di;
            LAS unsigned* L = (LAS unsigned*)F.lds;
            f32x4 cur[4][4], nxt[4][4];
            auto ld = [&](int itl, f32x4 (&v)[4][4]) { const int it = ct_global(0, itl);
                if (it < N_GU) { const int le = it / PER_GU, r = it % PER_GU; t8b_load(F.w_gu + (size_t)le * D * 2048, 2048, 128 * (r >> 3), 256 * (r & 7), F.wave, lane, v); }
                else { const int q = it - N_GU, le = q / PER_DN, r = q % PER_DN; t8b_load(F.w_down + (size_t)le * D * D, D, 128 * (r >> 2), 256 * (r & 3), F.wave, lane, v); } };
            auto st = [&](int itl, const f32x4 (&v)[4][4]) { const int it = ct_global(0, itl);
                if (it < N_GU) { const int le = it / PER_GU, r = it % PER_GU; t8b_store(v, D, WSP(unsigned char, WS_WGU) + (size_t)le * 2048 * D, dg, 128 * (r >> 3), 256 * (r & 7), L, F.wave, lane, WSCALE); }
                else { const int q = it - N_GU, le = q / PER_DN, r = q % PER_DN; t8b_store(v, D, WSP(unsigned char, WS_WDN) + (size_t)le * D * D, di, 128 * (r >> 2), 256 * (r & 3), L, F.wave, lane, WSCALE); } };
            int it = F.blk;
            if (it < NIT) ld(it, cur);
#pragma unroll 1
            for (; it < NIT; it += F.G) {
                const int itn = it + F.G;
                if (itn < NIT) ld(itn, nxt);
                st(it, cur);
#pragma unroll
                for (int j = 0; j < 4; ++j)
#pragma unroll
                    for (int r = 0; r < 4; ++r) cur[j][r] = nxt[j][r];
            }
        } else {
            { constexpr int PER = (D / 64) * (2048 / 32); const DestGu dg;
              for (int it = gw; it < DEPTH * NE * PER; it += NGW) { const int le = it / PER; transpose_item(F.w_gu + (size_t)le * D * 2048, D, 2048, WSP(bf16, WS_WGU) + (size_t)le * 2048 * D, dg, scr, it % PER, lane); } }
            { constexpr int PER = (D / 64) * (D / 32); const DestId di;
              for (int it = gw; it < DEPTH * NE * PER; it += NGW) { const int le = it / PER; transpose_item(F.w_down + (size_t)le * D * D, D, D, WSP(bf16, WS_WDN) + (size_t)le * D * D, di, scr, it % PER, lane); } }
        }
    }
}
__device__ __forceinline__ void phase_prologue(const Frame& F) {
    if (F.blk & 1) { prologue_moe(F); __syncthreads(); prologue_small(F); }
    else { prologue_small(F); __syncthreads(); prologue_moe(F); }
}

template <int MODEK>
__device__ __forceinline__ void phase_tokA(const Frame& F, const void* xsrc, bool src_f32, bool combine, bool writex, const float* modl_prev_g2, const float* gvec, const float* modl_sh, const float* modl_sc) {
    const int lane = lane_id(), t0 = F.blk * TPB + F.wave * (TPB / NWAVES), b = (F.blk * TPB) / S;
    void* X = WSP(void, WS_X); bf16* H = WSP(bf16, WS_H); const bf16* Y = WSP(bf16, WS_Y); const int* tokrow = WSP(int, WS_TOKROW);
    f32x4 scl[4], shf[4], g2v[4];
#pragma unroll
    for (int j = 0; j < 4; ++j) {
        const int ci = 64 * j + lane;
        scl[j] = ((const f32x4*)gvec)[ci]; shf[j] = (f32x4){0.f, 0.f, 0.f, 0.f}; g2v[j] = (f32x4){0.f, 0.f, 0.f, 0.f};
        if (MODEK == 1) { scl[j] = scl[j] * (((const f32x4*)(modl_sc + (size_t)b * 6 * D))[ci] + 1.f); shf[j] = ((const f32x4*)(modl_sh + (size_t)b * 6 * D))[ci]; }
        if (combine) g2v[j] = ((const f32x4*)(modl_prev_g2 + (size_t)b * 6 * D))[ci] * (Y_FP8 ? 1.f / YSCALE : 1.f);
    }
    static_assert(Y_FP8 && X_BF16, "pipelined token phase: fp8 Y rows, bf16 X");
    u32x4 xr[4]; unsigned yr[4][4]; int rn[4];
    auto issue = [&](int t, const int (&rows)[4]) {
#pragma unroll
        for (int j = 0; j < 4; ++j) {
            if (src_f32) xr[j] = *(const u32x4*)((const float*)xsrc + (size_t)t * D + 256 * j + 4 * lane);
            else { const u32x2 w = *(const u32x2*)((const unsigned short*)xsrc + (size_t)t * D + 256 * j + 4 * lane); xr[j] = (u32x4){w.x, w.y, 0u, 0u}; }
        }
        if (combine) {
#pragma unroll
            for (int k = 0; k < 4; ++k) { const unsigned* yp = (const unsigned*)((const unsigned char*)Y + (size_t)rows[k] * D);
#pragma unroll
                for (int j = 0; j < 4; ++j) yr[k][j] = yp[64 * j + lane]; }
        }
    };
    {
        int r0[4];
#pragma unroll
        for (int k = 0; k < 4; ++k) { r0[k] = combine ? tokrow[t0 * 4 + k] : 0; rn[k] = combine ? tokrow[(t0 + 1) * 4 + k] : 0; }
        issue(t0, r0);
    }
#pragma unroll 1
    for (int i = 0; i < TPB / NWAVES; ++i) {
        const int t = t0 + i;
        u32x4 xc[4]; unsigned yc[4][4];
#pragma unroll
        for (int j = 0; j < 4; ++j) { xc[j] = xr[j];
#pragma unroll
            for (int k = 0; k < 4; ++k) yc[k][j] = yr[k][j]; }
        if (i + 1 < TPB / NWAVES) {
            int rc[4];
#pragma unroll
            for (int k = 0; k < 4; ++k) rc[k] = rn[k];
            issue(t + 1, rc);
            const int t2 = min(t + 2, T - 1);
#pragma unroll
            for (int k = 0; k < 4; ++k) rn[k] = combine ? tokrow[t2 * 4 + k] : 0;
        }
        f32x4 xv[4];
#pragma unroll
        for (int j = 0; j < 4; ++j) xv[j] = src_f32 ? __builtin_bit_cast(f32x4, xc[j]) : (f32x4){bflo(xc[j].x), bfhi(xc[j].x), bflo(xc[j].y), bfhi(xc[j].y)};
        if (combine) {
            f32x4 a[4];
#pragma unroll
            for (int j = 0; j < 4; ++j) a[j] = (f32x4){0.f, 0.f, 0.f, 0.f};
#pragma unroll
            for (int k = 0; k < 4; ++k) {
#pragma unroll
                for (int j = 0; j < 4; ++j) { const unsigned w = yc[k][j]; const auto lo = __builtin_amdgcn_cvt_pk_f32_fp8((int)w, false), hi = __builtin_amdgcn_cvt_pk_f32_fp8((int)w, true); a[j] += (f32x4){lo[0], lo[1], hi[0], hi[1]}; }
            }
#pragma unroll
            for (int j = 0; j < 4; ++j) xv[j] += g2v[j] * a[j];
        }
        if (writex) {
#pragma unroll
            for (int j = 0; j < 4; ++j) xstore4(X, (size_t)t * D + 256 * j + 4 * lane, xv[j]);
        }
        if (MODEK != 0) {
            float ss = 0.f;
#pragma unroll
            for (int j = 0; j < 4; ++j) ss += (xv[j][0] * xv[j][0] + xv[j][1] * xv[j][1]) + (xv[j][2] * xv[j][2] + xv[j][3] * xv[j][3]);
            const float r = rsqrtf(wave_sum(ss) * KF(1.f / D) + KF(EPS));
#pragma unroll
            for (int j = 0; j < 4; ++j) {
                const f32x4 hv = xv[j] * r * scl[j] + shf[j];
                if (MODEK == 1) {
                    if (B_FP8) ((unsigned*)(WSP(unsigned char, WS_H8) + (size_t)t * D))[64 * j + lane] = pk4_fp8(hv[0] * HSCALE, hv[1] * HSCALE, hv[2] * HSCALE, hv[3] * HSCALE);
                    else { u32x2 w; w.x = pk2(hv[0], hv[1]); w.y = pk2(hv[2], hv[3]); ((u32x2*)(H + (size_t)t * D))[64 * j + lane] = w; } }
                else ((f32x4*)(F.out + (size_t)t * D))[64 * j + lane] = hv;
            }
        }
    }
}

constexpr int HB_PITCH = D + 4;
__device__ __forceinline__ void phase_tokH(const Frame& F, int l) {
    typedef float f32x4_t __attribute__((ext_vector_type(4)));
    const int lane = lane_id(), tid = F.wave * 64 + lane, wave = F.wave, b = (F.blk * TPB) / S;
    const void* X = WSP(void, WS_X); bf16* H = WSP(bf16, WS_H);
    int* tope = WSP(int, WS_TOPE); float* topg = WSP(float, WS_TOPG); int* lrank = WSP(int, WS_LRANK); int* hist = WSP(int, WS_HIST);
    LAS float* hbuf = (LAS float*)F.lds;
    LAS float* part = (LAS float*)(F.lds + 16 * HB_PITCH * 4);
    LAS int* lhist = (LAS int*)(F.lds + MISC_OFF + 256);
    if (tid < NE) lhist[tid] = 0;
    const float* rwt = WSP(float, WS_RWT) + (size_t)l * NE * D;
    f32x4 Bw[8][2];
#pragma unroll
    for (int s8 = 0; s8 < 8; ++s8)
#pragma unroll
        for (int eh = 0; eh < 2; ++eh) Bw[s8][eh] = *(const f32x4*)(rwt + (size_t)(eh * 16 + (lane & 15)) * D + wave * 128 + 16 * s8 + 4 * (lane >> 4));
    const float* modl = WSP(float, WS_MOD) + (size_t)l * NB * 6 * D + (size_t)b * 6 * D;
    f32x4 scl[4], shf[4];
#pragma unroll
    for (int j = 0; j < 4; ++j) { const int ci = 64 * j + lane; scl[j] = ((const f32x4*)(F.norm2_g + l * D))[ci] * (((const f32x4*)(modl + 4 * D))[ci] + 1.f); shf[j] = ((const f32x4*)(modl + 3 * D))[ci]; }
    const float rbias = F.router_b[l * NE + (lane & 31)];
    __syncthreads();
#pragma unroll 1
    for (int c = 0; c < TPB / 16; ++c) {
#pragma unroll
        for (int tt = 0; tt < 2; ++tt) {
            const int tl = wave * 2 + tt, t = F.blk * TPB + c * 16 + tl;
            f32x4 xv[4]; float ss = 0.f;
#pragma unroll
            for (int j = 0; j < 4; ++j) { xv[j] = xload4(X, (size_t)t * D + 256 * j + 4 * lane, false); ss += (xv[j][0] * xv[j][0] + xv[j][1] * xv[j][1]) + (xv[j][2] * xv[j][2] + xv[j][3] * xv[j][3]); }
            const float r = rsqrtf(wave_sum(ss) * KF(1.f / D) + KF(EPS));
#pragma unroll
            for (int j = 0; j < 4; ++j) {
                const f32x4 h4 = xv[j] * r * scl[j] + shf[j];
                if (MOE_FP8) ((unsigned*)(WSP(unsigned char, WS_H8) + (size_t)t * D))[64 * j + lane] = pk4_fp8(h4[0] * HSCALE, h4[1] * HSCALE, h4[2] * HSCALE, h4[3] * HSCALE);
                else { u32x2 w; w.x = pk2(h4[0], h4[1]); w.y = pk2(h4[2], h4[3]); ((u32x2*)(H + (size_t)t * D))[64 * j + lane] = w; }
                *(LAS f32x4*)(hbuf + tl * HB_PITCH + 256 * j + 4 * lane) = h4;
            }
        }
        __syncthreads();
        {
            f32x4 acc0 = {0.f, 0.f, 0.f, 0.f}, acc1 = {0.f, 0.f, 0.f, 0.f};
            const LAS float* ap = hbuf + (lane & 15) * HB_PITCH + wave * 128 + 4 * (lane >> 4);
#pragma unroll
            for (int s8 = 0; s8 < 8; ++s8) {
                const f32x4 a = *(const LAS f32x4*)(ap + 16 * s8);
#pragma unroll
                for (int i = 0; i < 4; ++i) {
                    acc0 = __builtin_amdgcn_mfma_f32_16x16x4f32(a[i], Bw[s8][0][i], acc0, 0, 0, 0);
                    acc1 = __builtin_amdgcn_mfma_f32_16x16x4f32(a[i], Bw[s8][1][i], acc1, 0, 0, 0);
                }
            }
            LAS float* pp = part + wave * 512 + (4 * (lane >> 4)) * 32 + (lane & 15);
#pragma unroll
            for (int q = 0; q < 4; ++q) { pp[q * 32] = acc0[q]; pp[q * 32 + 16] = acc1[q]; }
        }
        __syncthreads();
        {
            const int tl = wave * 2 + (lane >> 5), e = lane & 31, t = F.blk * TPB + c * 16 + tl;
            float logit = rbias;
#pragma unroll
            for (int w = 0; w < NWAVES; ++w) logit += part[w * 512 + tl * 32 + e];
            float vals[4]; int idx[4];
#pragma unroll
            for (int k = 0; k < 4; ++k) {
                float m = logit; int mi = e;
#pragma unroll
                for (int o = 1; o < 32; o <<= 1) { const float om = __shfl_xor(m, o); const int oi = __shfl_xor(mi, o); if (om > m || (om == m && oi < mi)) { m = om; mi = oi; } }
                vals[k] = m; idx[k] = mi; if (e == mi) logit = KF(-3.0e38f);
            }
            const float e1 = fexp(vals[1] - vals[0]), e2 = fexp(vals[2] - vals[0]), e3 = fexp(vals[3] - vals[0]);
            const float inv = 1.f / (1.f + e1 + e2 + e3);
            if (e < 4) {
                const int myi = e == 0 ? idx[0] : (e == 1 ? idx[1] : (e == 2 ? idx[2] : idx[3]));
                const float myg = (e == 0 ? 1.f : (e == 1 ? e1 : (e == 2 ? e2 : e3))) * inv;
                tope[t * 4 + e] = myi; topg[t * 4 + e] = myg;
                lrank[t * 4 + e] = __hip_atomic_fetch_add(lhist + myi, 1, __ATOMIC_RELAXED, __HIP_MEMORY_SCOPE_WORKGROUP);
            }
        }
    }
    __syncthreads();
    if (tid < NE) hist[F.blk * NE + tid] = lhist[tid];
    __syncthreads();
}

__device__ __forceinline__ void phase_route(const Frame& F) {
    const int tid = F.wave * 64 + lane_id();
    const int* hist = WSP(int, WS_HIST); const int* tope = WSP(int, WS_TOPE); const float* topg = WSP(float, WS_TOPG); const int* lrank = WSP(int, WS_LRANK);
    int* rowtok = WSP(int, WS_ROWTOK); float* rowgate = WSP(float, WS_ROWGATE); int* tokrow = WSP(int, WS_TOKROW); int* tileexp = WSP(int, WS_TILEEXP);
    LAS int* tp = (LAS int*)F.lds; LAS int* pp = tp + 512; LAS int* tot = pp + 512; LAS int* pre = tot + 32; LAS int* base = pre + 32;
    {
        const int e = tid & 31, part = tid >> 5; int a = 0, p = 0;
        for (int q = 0; q < GRID / 16; ++q) { const int bb = part * (GRID / 16) + q; const int v = hist[bb * NE + e]; a += v; p += (bb < F.blk) ? v : 0; }
        tp[part * 32 + e] = a; pp[part * 32 + e] = p;
    }
    __syncthreads();
    if (tid < NE) { int a = 0, p = 0; for (int q = 0; q < 16; ++q) { a += tp[q * 32 + tid]; p += pp[q * 32 + tid]; } tot[tid] = a; pre[tid] = p; }
    __syncthreads();
    if (tid == 0) { int s = 0; for (int e = 0; e < NE; ++e) { base[e] = s; s += (tot[e] + RPAD - 1) / RPAD * RPAD; } base[NE] = s; }
    __syncthreads();
    {
        const int a = F.blk * (TPB * TOPK) + tid;
        const int e = tope[a]; const int row = base[e] + pre[e] + lrank[a];
        rowtok[row] = a >> 2; rowgate[row] = topg[a]; tokrow[a] = row;
    }
    if (F.blk < NE) {
        const int e = F.blk;
        for (int r = base[e] + tot[e] + tid; r < base[e + 1]; r += NTHREADS) { rowtok[r] = 0; rowgate[r] = 0.f; }
        for (int tl = base[e] / RPAD + tid; tl < base[e + 1] / RPAD; tl += NTHREADS) tileexp[tl] = e;
    }
    if (F.blk == 0 && tid == 0) tileexp[NRT_SLOT] = base[NE] / RPAD;
    __syncthreads();
}

__device__ __forceinline__ unsigned kv_off(unsigned row, unsigned ch) { const unsigned f = (((row >> 1) & 1u) << 2) | (((row >> 2) & 1u) << 1) | ((row >> 3) & 1u); return row * 128u + ((ch ^ f) << 4); }
__device__ __forceinline__ int crow(int reg, int h) { return (reg & 3) + 8 * (reg >> 2) + 4 * h; }

__device__ __forceinline__ void phase_attn_pool(const Frame& F) {
    const int lane = lane_id(), tid = F.wave * 64 + lane, wave = F.wave, half = wave >> 2, w4 = wave & 3, th = tid & 255;
    const int r5 = lane & 31, h = lane >> 5, blk16 = (lane >> 4) & 1, q4 = (lane & 15) >> 2, p4 = lane & 3;
    const bf16* Qb = WSP(bf16, WS_Q); const bf16* Kb = WSP(bf16, WS_K); const bf16* Vb = WSP(bf16, WS_V);
    bf16* OG = WSP(bf16, WS_OG); float* LSE = WSP(float, WS_LSE);
    LAS unsigned char* Kimg = F.lds + half * 65536; LAS unsigned char* Vimg = Kimg + 32768;
    constexpr float SC = 0.18033688011112042f;
    constexpr int NSUB = NB * 12 * 16;
    u32x4 kr[8], vr[8];
    auto stage_load = [&](int pr_) {
        const int su = pr_ * 2 + half; const int rb = su & 15, bgh = su >> 4, gh = bgh % 12, b = bgh / 12, g = gh >> 2;
        const int dil = (g == 0) ? 1 : (g == 1 ? 4 : 16), L = S / dil, nblk = L / 128; const int r = rb / nblk, qblk = rb % nblk, kb0 = qblk * 128 - 64;
#pragma unroll
        for (int p = 0; p < 8; ++p) {
            const int idx = p * 256 + th, row = idx >> 3, ch = idx & 7, key = kb0 + row;
            if (key >= 0 && key < L) { const size_t go = (size_t)(b * S + key * dil + r) * 768 + gh * 64 + ch * 8; kr[p] = *(const u32x4*)(Kb + go); vr[p] = *(const u32x4*)(Vb + go); }
            else { kr[p] = (u32x4){0u, 0u, 0u, 0u}; vr[p] = kr[p]; }
        }
    };
    if (F.blk < NSUB / 2) stage_load(F.blk);
    for (int pr = F.blk; pr < NSUB / 2; pr += F.G) {
        const int su = pr * 2 + half;
        const int rb = su & 15, bgh = su >> 4, gh = bgh % 12, b = bgh / 12, g = gh >> 2;
        const int dil = (g == 0) ? 1 : (g == 1 ? 4 : 16), L = S / dil, nblk = L / 128;
        const int r = rb / nblk, qblk = rb % nblk;
        __syncthreads();
#pragma unroll
        for (int p = 0; p < 8; ++p) {
            const int idx = p * 256 + th, row = idx >> 3, ch = idx & 7; const unsigned o = kv_off(row, ch);
            *(LAS u32x4*)(Kimg + o) = kr[p]; *(LAS u32x4*)(Vimg + o) = vr[p];
        }
        const int m0 = qblk * 128 + w4 * 32;
        const int tq = b * S + (m0 + r5) * dil + r;
        bf16x8 qf[4];
#pragma unroll
        for (int ks = 0; ks < 4; ++ks) qf[ks] = *(const bf16x8*)(Qb + (size_t)tq * 768 + gh * 64 + 16 * ks + 8 * h);
        asm volatile("s_waitcnt lgkmcnt(0)" ::: "memory");
        if (pr + F.G < NSUB / 2) stage_load(pr + F.G);
        __syncthreads();
        float m_run = -1e30f, l_run = 0.f;
        f32x16 o0, o1;
#pragma unroll
        for (int e = 0; e < 16; ++e) { o0[e] = 0.f; o1[e] = 0.f; }
        for (int it = 0; it < 5; ++it) {
            const int kt = m0 - 64 + 32 * it;
            if (kt < 0 || kt >= L) continue;
            const unsigned lrow0 = (unsigned)(w4 * 32 + 32 * it);
            f32x16 s;
#pragma unroll
            for (int e = 0; e < 16; ++e) s[e] = 0.f;
#pragma unroll
            for (int ks = 0; ks < 4; ++ks) {
                const bf16x8 a = *(const LAS bf16x8*)(Kimg + kv_off(lrow0 + r5, 2 * ks + h));
                s = __builtin_amdgcn_mfma_f32_32x32x16_bf16(a, qf[ks], s, 0, 0, 0);
            }
            if (it == 0) {
#pragma unroll
                for (int e = 0; e < 16; ++e) if (crow(e, h) < r5) s[e] = -1e30f;
            }
            if (it == 4) {
#pragma unroll
                for (int e = 0; e < 16; ++e) if (crow(e, h) > r5) s[e] = -1e30f;
            }
            float mx = s[0];
#pragma unroll
            for (int e = 1; e < 16; ++e) mx = fmaxf(mx, s[e]);
            mx = fmaxf(mx, __shfl_xor(mx, 32));
            const float m_new = fmaxf(m_run, mx), alpha = __builtin_amdgcn_exp2f((m_run - m_new) * SC);
            m_run = m_new;
            float psum = 0.f;
#pragma unroll
            for (int e = 0; e < 16; ++e) { const float p = __builtin_amdgcn_exp2f((s[e] - m_new) * SC); s[e] = p; psum += p; }
            l_run = l_run * alpha + psum;
#pragma unroll
            for (int e = 0; e < 16; ++e) { o0[e] *= alpha; o1[e] *= alpha; }
            bf16x8 pb[2];
#pragma unroll
            for (int st = 0; st < 2; ++st) { u32x4 w; w.x = pk2(s[8 * st], s[8 * st + 1]); w.y = pk2(s[8 * st + 2], s[8 * st + 3]); w.z = pk2(s[8 * st + 4], s[8 * st + 5]); w.w = pk2(s[8 * st + 6], s[8 * st + 7]); pb[st] = __builtin_bit_cast(bf16x8, w); }
            s16x4 vt[2][2][2];
            {
                unsigned ad[2][2][2];
#pragma unroll
                for (int c = 0; c < 2; ++c)
#pragma unroll
                    for (int st = 0; st < 2; ++st)
#pragma unroll
                        for (int tt = 0; tt < 2; ++tt)
                            ad[c][st][tt] = (unsigned)(size_t)Vimg + kv_off(lrow0 + 16 * st + 8 * tt + 4 * h + q4, 4 * c + 2 * blk16 + (p4 >> 1)) + 8 * (p4 & 1);
                asm volatile("ds_read_b64_tr_b16 %0, %8\n\tds_read_b64_tr_b16 %1, %9\n\tds_read_b64_tr_b16 %2, %10\n\tds_read_b64_tr_b16 %3, %11\n\t"
                             "ds_read_b64_tr_b16 %4, %12\n\tds_read_b64_tr_b16 %5, %13\n\tds_read_b64_tr_b16 %6, %14\n\tds_read_b64_tr_b16 %7, %15\n\ts_waitcnt lgkmcnt(0)"
                             : "=&v"(vt[0][0][0]), "=&v"(vt[0][0][1]), "=&v"(vt[0][1][0]), "=&v"(vt[0][1][1]), "=&v"(vt[1][0][0]), "=&v"(vt[1][0][1]), "=&v"(vt[1][1][0]), "=&v"(vt[1][1][1])
                             : "v"(ad[0][0][0]), "v"(ad[0][0][1]), "v"(ad[0][1][0]), "v"(ad[0][1][1]), "v"(ad[1][0][0]), "v"(ad[1][0][1]), "v"(ad[1][1][0]), "v"(ad[1][1][1])
                             : "memory");
            }
#pragma unroll
            for (int st = 0; st < 2; ++st) {
                const bf16x8 a0 = __builtin_shufflevector(vt[0][st][0], vt[0][st][1], 0, 1, 2, 3, 4, 5, 6, 7);
                const bf16x8 a1 = __builtin_shufflevector(vt[1][st][0], vt[1][st][1], 0, 1, 2, 3, 4, 5, 6, 7);
                o0 = __builtin_amdgcn_mfma_f32_32x32x16_bf16(a0, pb[st], o0, 0, 0, 0);
                o1 = __builtin_amdgcn_mfma_f32_32x32x16_bf16(a1, pb[st], o1, 0, 0, 0);
            }
        }
        const float l_tot = l_run + __shfl_xor(l_run, 32), inv_l = 1.f / l_tot;
        bf16* op = OG + (size_t)tq * 768 + gh * 64;
#pragma unroll
        for (int g4 = 0; g4 < 4; ++g4) {
            u32x2 w0, w1;
            w0.x = pk2(o0[4 * g4] * inv_l, o0[4 * g4 + 1] * inv_l); w0.y = pk2(o0[4 * g4 + 2] * inv_l, o0[4 * g4 + 3] * inv_l);
            w1.x = pk2(o1[4 * g4] * inv_l, o1[4 * g4 + 1] * inv_l); w1.y = pk2(o1[4 * g4 + 2] * inv_l, o1[4 * g4 + 3] * inv_l);
            *(u32x2*)(op + 8 * g4 + 4 * h) = w0; *(u32x2*)(op + 32 + 8 * g4 + 4 * h) = w1;
        }
        if (h == 0) LSE[(size_t)tq * 12 + gh] = m_run * 0.125f + flog(l_tot);
    }
    {
        const bf16* U = WSP(bf16, WS_U); bf16* AD = WSP(bf16, WS_AD);
        const int tseg = F.blk * TPB + wave * 16 + (lane >> 4) * 4, sseg = tseg & (S - 1), tb = tseg - sseg;
#define POOL_GROUP(G)                                                                                                                         \
        {   constexpr int HW = 1 << (G), NR = 2 * HW + 4; const int ch = (G) * 16 + (lane & 15);                                                \
            u32x4 rw[NR];                                                                                                                       \
            _Pragma("unroll") for (int q = 0; q < NR; ++q) { const int p = sseg - HW + q; const bool ok = (p >= 0) && (p < S);                  \
                rw[q] = ok ? *(const u32x4*)(U + (size_t)(tb + p) * 512 + ch * 8) : (u32x4){0u, 0u, 0u, 0u}; }                                  \
            float a[8];                                                                                                                         \
            _Pragma("unroll") for (int e = 0; e < 8; ++e) a[e] = 0.f;                                                                           \
            _Pragma("unroll") for (int q = 0; q < 2 * HW; ++q) { a[0] += bflo(rw[q].x); a[1] += bfhi(rw[q].x); a[2] += bflo(rw[q].y); a[3] += bfhi(rw[q].y); \
                a[4] += bflo(rw[q].z); a[5] += bfhi(rw[q].z); a[6] += bflo(rw[q].w); a[7] += bfhi(rw[q].w); }                                   \
            _Pragma("unroll") for (int i = 0; i < 4; ++i) {                                                                                     \
                const int s = sseg + i; const float inv = 1.f / (float)(min(s + HW, S) - max(s - HW, 0)); const u32x4 w = rw[HW + i]; u32x4 o;   \
                o.x = pk2(a[0] * inv - bflo(w.x), a[1] * inv - bfhi(w.x)); o.y = pk2(a[2] * inv - bflo(w.y), a[3] * inv - bfhi(w.y));            \
                o.z = pk2(a[4] * inv - bflo(w.z), a[5] * inv - bfhi(w.z)); o.w = pk2(a[6] * inv - bflo(w.w), a[7] * inv - bfhi(w.w));            \
                *(u32x4*)(AD + (size_t)(tseg + i) * 768 + 256 + ch * 8) = o;                                                                     \
                if (i < 3) { const u32x4 pl = rw[2 * HW + i], mi = rw[i];                                                                        \
                    a[0] += bflo(pl.x) - bflo(mi.x); a[1] += bfhi(pl.x) - bfhi(mi.x); a[2] += bflo(pl.y) - bflo(mi.y); a[3] += bfhi(pl.y) - bfhi(mi.y); \
                    a[4] += bflo(pl.z) - bflo(mi.z); a[5] += bfhi(pl.z) - bfhi(mi.z); a[6] += bflo(pl.w) - bflo(mi.w); a[7] += bfhi(pl.w) - bfhi(mi.w); } \
            }                                                                                                                                   \
        }
        POOL_GROUP(0) POOL_GROUP(1) POOL_GROUP(2) POOL_GROUP(3)
#undef POOL_GROUP
    }
}

__device__ __forceinline__ void phase_attn_combine(const Frame& F) {
    const bf16* OG = WSP(bf16, WS_OG); const float* LSE = WSP(float, WS_LSE); bf16* AD = WSP(bf16, WS_AD);
    const int lane = lane_id(), hh = lane >> 4, d0 = (lane & 15) * 4;
#pragma unroll 2
    for (int i = 0; i < TPB / NWAVES; ++i) {
        const int t = F.blk * TPB + F.wave * (TPB / NWAVES) + i;
        const float l0 = LSE[(size_t)t * 12 + hh], l1 = LSE[(size_t)t * 12 + 4 + hh], l2 = LSE[(size_t)t * 12 + 8 + hh];
        const float m = fmaxf(l0, fmaxf(l1, l2)), e0 = fexp(l0 - m), e1 = fexp(l1 - m), e2 = fexp(l2 - m), inv = 1.f / (e0 + e1 + e2);
        const u32x2 a = *(const u32x2*)(OG + (size_t)t * 768 + hh * 64 + d0), bq = *(const u32x2*)(OG + (size_t)t * 768 + (4 + hh) * 64 + d0), c = *(const u32x2*)(OG + (size_t)t * 768 + (8 + hh) * 64 + d0);
        const float w0 = e0 * inv, w1 = e1 * inv, w2 = e2 * inv;
        u32x2 o;
        o.x = pk2(w0 * bflo(a.x) + w1 * bflo(bq.x) + w2 * bflo(c.x), w0 * bfhi(a.x) + w1 * bfhi(bq.x) + w2 * bfhi(c.x));
        o.y = pk2(w0 * bflo(a.y) + w1 * bflo(bq.y) + w2 * bflo(c.y), w0 * bfhi(a.y) + w1 * bfhi(bq.y) + w2 * bfhi(c.y));
        *(u32x2*)(AD + (size_t)t * 768 + hh * 64 + d0) = o;
    }
}

constexpr int PH_PER_LAYER = 11, PH_FINAL = 1 + DEPTH * PH_PER_LAYER, NPHASE = PH_FINAL + 1;

__global__ void __launch_bounds__(NTHREADS, 2) mega_fwd(Args args) {
    extern __shared__ __attribute__((aligned(16))) unsigned char lds_raw[];
    LAS unsigned char* const lds0 = (LAS unsigned char*)lds_raw; const int wave0 = __builtin_amdgcn_readfirstlane((int)threadIdx.x >> 6);
#define MKF const Frame F = make_frame(kargs(), lds0, wave0)
    volatile LAS unsigned* MISC = (volatile LAS unsigned*)(lds0 + MISC_OFF);
    for (int u = threadIdx.x; u < (LDS_BYTES - MISC_OFF) / 4; u += NTHREADS) ((LAS unsigned*)(lds0 + MISC_OFF))[u] = 0u;
#if MODE != 0
    for (int u = threadIdx.x; u < MISC_OFF / 4; u += NTHREADS) ((LAS unsigned*)lds0)[u] = (args.flags & 16) ? 0x3f803f80u : 0xFFFFFFFFu;
#endif
    __syncthreads();
    unsigned* ctl = (unsigned*)(args.ws + WS_CTL);
    XcdBarrier bar = xcd_barrier_post(ctl + CW_BAR + args.li * BAR_REGION_WORDS, MISC + 8, threadIdx.x == 0);
    const int lo = args.ph_lo, hi = args.ph_hi;
    const bool nocomb = (args.flags & 1) != 0;
#define IN(k) (lo <= (k) && (k) < hi)
#define SEAM(k) do { if (IN(k) && IN((k) + 1)) xcd_barrier(bar, wave0 == 0 && lane_id() == 0); } while (0)

    if (IN(0)) { REP(-2) { MKF; phase_prologue(F); } SEAM(0); }
    for (int l = 0; l < DEPTH; ++l) {
        const int pb = 1 + l * PH_PER_LAYER;
        if (IN(pb + 0)) {
            REP(0) {
            MKF; void* X = WSP(void, WS_X); const float* modl = WSP(float, WS_MOD) + (size_t)l * NB * 6 * D;
            const bool comb = (l > 0) && !nocomb; const bool first = (l == 0 && !nocomb);
            phase_tokA<1>(F, first ? (const void*)F.x_in : (const void*)X, first, comb, comb, modl - (size_t)NB * 6 * D + 5 * D, F.norm1_g + l * D, modl + 0 * D, modl + 1 * D);
            }
            SEAM(pb + 0);
        }
        if (IN(pb + 1)) {
            REP(1) {
            MKF;
            DenseSched Sd; Sd.so.init(T / BM, IN_COLS / BM, F.G, F.blk); constexpr int BB = B_FP8 ? 1 : 2;
            Sd.A = B_FP8 ? (const char*)WSP(unsigned char, WS_H8) : (const char*)WSP(bf16, WS_H); Sd.Bt = (const char*)WSP(unsigned char, WS_WIN) + (size_t)l * IN_COLS * D * BB; Sd.lda = D * BB / 2; Sd.K = D * BB / 2;
            EpiProj E{WSP(bf16, WS_Q), WSP(bf16, WS_K), WSP(bf16, WS_V), WSP(bf16, WS_U), WSP(bf16, WS_GA), WSP(bf16, WS_GP), WSP(float, WS_ROPE)};
            gemm_phase<EpiProj, DenseSched, true, B_FP8 != 0>(F.lds, D * BB / 2, Sd, E, F.wave);
            if (MOE_FP8) tail_convert(F, l < 1 ? 1 : l, TAIL_B * spare_units((T / BM) * (IN_COLS / BM), F.G, F.blk));
            }
            SEAM(pb + 1);
        }
        if (IN(pb + 2)) { REP(2) { MKF; phase_attn_pool(F); } SEAM(pb + 2); }
        if (IN(pb + 3)) {
            REP(3) {
            MKF; phase_attn_combine(F);
            DenseSched Sd; Sd.so.init(T / BM, D / BM, F.G, F.blk); Sd.A = (const char*)(WSP(bf16, WS_AD) + 256); Sd.Bt = (const char*)(WSP(bf16, WS_WP) + (size_t)l * D * 512); Sd.lda = 768; Sd.K = 512;
            EpiGate E{WSP(bf16, WS_GP), WSP(bf16, WS_MA)};
            __syncthreads();
            gemm_phase<EpiGate, DenseSched, true>(F.lds, 512, Sd, E, F.wave);
            }
            SEAM(pb + 3);
        }
        if (IN(pb + 4)) {
            REP(4) {
            MKF;
            DenseSched Sd; Sd.so.init(T / BM, D / BM, F.G, F.blk); Sd.A = (const char*)WSP(bf16, WS_AD); Sd.Bt = (const char*)(WSP(bf16, WS_WA) + (size_t)l * D * 256); Sd.lda = 768; Sd.K = 256;
            EpiGateAdd E{WSP(bf16, WS_GA), WSP(bf16, WS_MA), WSP(bf16, WS_MG)};
            gemm_phase<EpiGateAdd, DenseSched, true>(F.lds, 256, Sd, E, F.wave);
            }
            SEAM(pb + 4);
        }
        if (IN(pb + 6)) {
            REP(6) {
            MKF; void* X = WSP(void, WS_X); const float* modl = WSP(float, WS_MOD) + (size_t)l * NB * 6 * D; const bool first = (l == 0 && !nocomb);
            DenseSched Sd; Sd.so.init(T / BM, D / BM, F.G, F.blk); constexpr int GB = G_FP8 ? 1 : 2;
            Sd.A = (const char*)WSP(bf16, WS_MG); Sd.Bt = (const char*)WSP(unsigned char, WS_WOUT) + (size_t)l * D * D * GB; Sd.lda = D * GB / 2; Sd.K = D * GB / 2;
            EpiXres E{first ? (const void*)F.x_in : (const void*)X, X, modl + 2 * D, first};
            gemm_phase<EpiXres, DenseSched, true, G_FP8 != 0>(F.lds, D * GB / 2, Sd, E, F.wave);
            }
            SEAM(pb + 6);
        }
        if (IN(pb + 7)) { REP(7) { MKF; phase_tokH(F, l); } SEAM(pb + 7); }
        if (IN(pb + 8)) { REP(8) { MKF; phase_route(F); if (MOE_FP8 && l > 0) { if (DRAIN_STATIC) drain_static(F, l); else drain_convert(F, l); } } SEAM(pb + 8); }
        if (IN(pb + 9)) {
            REP(9) {
            MKF;
            const int* tileexp = WSP(int, WS_TILEEXP); const int nrt = tileexp[NRT_SLOT];
            MoeSched<true> Sm; Sm.so.init(nrt, 8, F.G, F.blk); Sm.A = MOE_FP8 ? (const char*)WSP(unsigned char, WS_H8) : (const char*)WSP(bf16, WS_H); Sm.Bt = (const char*)WSP(unsigned char, WS_WGU) + (size_t)l * NE * 2048 * D * EB; Sm.lda = D * EB / 2; Sm.K = D * EB / 2;
            Sm.estride = (size_t)2048 * D * EB; Sm.tile_exp = tileexp; Sm.row_token = WSP(int, WS_ROWTOK);
            EpiSwiglu E{WSP(bf16, WS_ACT), F.b_gu + (size_t)l * NE * 2048, tileexp};
            gemm_phase<EpiSwiglu, MoeSched<true>, true, MOE_FP8 != 0>(F.lds, D * EB / 2, Sm, E, F.wave);
            if (MOE_FP8) tail_convert(F, l + 1, TAIL_J * spare_units(nrt * 8, F.G, F.blk));
            }
            SEAM(pb + 9);
        }
        if (IN(pb + 10)) {
            REP(10) {
            MKF;
            const int* tileexp = WSP(int, WS_TILEEXP); const int nrt = tileexp[NRT_SLOT];
            MoeSched<false> Sm; Sm.so.init(nrt, 4, F.G, F.blk, true, 16); Sm.A = (const char*)WSP(bf16, WS_ACT); Sm.Bt = (const char*)WSP(unsigned char, WS_WDN) + (size_t)l * NE * D * D * EB; Sm.lda = D * EB / 2; Sm.K = D * EB / 2;
            Sm.estride = (size_t)D * D * EB; Sm.tile_exp = tileexp; Sm.row_token = nullptr;
            EpiDown E{WSP(bf16, WS_Y), F.b_down + (size_t)l * NE * D, tileexp, WSP(float, WS_ROWGATE)};
            gemm_phase<EpiDown, MoeSched<false>, true, MOE_FP8 != 0>(F.lds, D * EB / 2, Sm, E, F.wave);
            if (MOE_FP8) tail_convert(F, l + 1, TAIL_K * spare_units(nrt * 4, F.G, F.blk));
            }
            SEAM(pb + 10);
        }
    }
    if (IN(PH_FINAL)) {
        MKF; void* X = WSP(void, WS_X); const float* mod = WSP(float, WS_MOD);
#if defined(EXTRA_PH)
        {
            const int l = DEPTH - 1; const float* modl = mod + (size_t)l * NB * 6 * D;
#if EXTRA_PH == 7
            phase_tokH(F, l);
#elif EXTRA_PH == 0
            phase_tokA<1>(F, X, false, true, false, modl + 5 * D, F.norm1_g + l * D, modl + 0 * D, modl + 1 * D);
#elif EXTRA_PH == 10
            { const int* tileexp = WSP(int, WS_TILEEXP); const int nrt = tileexp[NRT_SLOT];
              MoeSched<false> Sm; Sm.so.init(nrt, 4, F.G, F.blk, true, 16); Sm.A = (const char*)WSP(bf16, WS_ACT); Sm.Bt = (const char*)WSP(unsigned char, WS_WDN) + (size_t)l * NE * D * D * EB; Sm.lda = D * EB / 2; Sm.K = D * EB / 2;
              Sm.estride = (size_t)D * D * EB; Sm.tile_exp = tileexp; Sm.row_token = nullptr;
              EpiDown E{WSP(bf16, WS_Y), F.b_down + (size_t)l * NE * D, tileexp, WSP(float, WS_ROWGATE)};
              gemm_phase<EpiDown, MoeSched<false>, true, MOE_FP8 != 0>(F.lds, D * EB / 2, Sm, E, F.wave); }
#elif EXTRA_PH >= 300
            prologue_small(F, opaque_s(EXTRA_PH - 300));
#elif EXTRA_PH == 101
            prologue_small(F);
#elif EXTRA_PH == 102
            prologue_moe(F);
#elif EXTRA_PH == 100
            phase_prologue(F);
#elif EXTRA_PH == 9
            { const int* tileexp = WSP(int, WS_TILEEXP); const int nrt = tileexp[NRT_SLOT];
              MoeSched<true> Sm; Sm.so.init(nrt, 8, F.G, F.blk); Sm.A = MOE_FP8 ? (const char*)WSP(unsigned char, WS_H8) : (const char*)WSP(bf16, WS_H); Sm.Bt = (const char*)WSP(unsigned char, WS_WGU) + (size_t)l * NE * 2048 * D * EB; Sm.lda = D * EB / 2; Sm.K = D * EB / 2;
              Sm.estride = (size_t)2048 * D * EB; Sm.tile_exp = tileexp; Sm.row_token = WSP(int, WS_ROWTOK);
              EpiSwiglu E{WSP(bf16, WS_ACT), F.b_gu + (size_t)l * NE * 2048, tileexp};
              gemm_phase<EpiSwiglu, MoeSched<true>, true, MOE_FP8 != 0>(F.lds, D * EB / 2, Sm, E, F.wave); }
#endif
            xcd_barrier(bar, wave0 == 0 && lane_id() == 0);
        }
#endif
        const float* modl = mod + (size_t)(DEPTH - 1) * NB * 6 * D;
        if (args.flags & 2) phase_tokA<0>(F, X, false, true, true, mod + (size_t)(args.flags >> 8) * NB * 6 * D + 5 * D, F.final_g, nullptr, nullptr);
        else phase_tokA<2>(F, X, false, true, false, modl + 5 * D, F.final_g, nullptr, nullptr);
    }
#undef IN
#undef SEAM
}
}

#if MODE != 0
namespace nv {
using namespace mk;
constexpr int QOFF = 0, KOFF = 768, VOFF = 1536, UOFF = 2304, GAOFF = 2816, GPOFF = 3840;
__global__ void k_copy(const float* __restrict__ a, float* __restrict__ b, size_t n4) { size_t i = (size_t)blockIdx.x * blockDim.x + threadIdx.x; if (i < n4) ((float4*)b)[i] = ((const float4*)a)[i]; }
__global__ void k_mod(const float* __restrict__ c, const float* __restrict__ ada_w, const float* __restrict__ ada_b, float* __restrict__ mod) {
    __shared__ float cs[NB][64];
    const int l = blockIdx.y, j = blockIdx.x * 256 + threadIdx.x;
    float acc[NB];
#pragma unroll
    for (int b = 0; b < NB; ++b) acc[b] = 0.f;
    for (int k0 = 0; k0 < D; k0 += 64) {
        __syncthreads();
        for (int i = threadIdx.x; i < NB * 64; i += 256) { int b = i / 64, kk = i % 64; float v = c[b * D + k0 + kk]; cs[b][kk] = v / (1.f + expf(-v)); }
        __syncthreads();
        for (int kk = 0; kk < 64; ++kk) { float w = ada_w[((size_t)l * D + k0 + kk) * (6 * D) + j];
#pragma unroll
            for (int b = 0; b < NB; ++b) acc[b] += cs[b][kk] * w; }
    }
#pragma unroll
    for (int b = 0; b < NB; ++b) mod[((size_t)l * NB + b) * (6 * D) + j] = acc[b] + ada_b[l * 6 * D + j];
}
__global__ void k_rope_table(float* __restrict__ cs) {
    int i = blockIdx.x * blockDim.x + threadIdx.x; if (i >= S * 8) return;
    int s = i / 8, j = i % 8; float inv = (float)pow(500000.0, -(double)(2 * j) / 16.0); float ang = (float)s * inv;
    cs[s * 16 + j] = (float)cos((double)ang); cs[s * 16 + 8 + j] = (float)sin((double)ang);
}
__device__ __forceinline__ float wsum(float v) {
#pragma unroll
    for (int o = 32; o > 0; o >>= 1) v += __shfl_xor(v, o);
    return v; }
__device__ __forceinline__ float wmax(float v) {
#pragma unroll
    for (int o = 32; o > 0; o >>= 1) v = fmaxf(v, __shfl_xor(v, o));
    return v; }
__global__ void k_norm_mod(const float* __restrict__ x, const float* __restrict__ g, const float* __restrict__ sh, const float* __restrict__ sc, float* __restrict__ h) {
    __shared__ float red[4];
    const int t = blockIdx.x, b = t / S, tid = threadIdx.x;
    float4 v = ((const float4*)(x + (size_t)t * D))[tid];
    float ss = wsum(v.x * v.x + v.y * v.y + v.z * v.z + v.w * v.w);
    if ((tid & 63) == 0) red[tid >> 6] = ss;
    __syncthreads();
    float r = rsqrtf((red[0] + red[1] + red[2] + red[3]) * (1.f / D) + EPS);
    float4 gg = ((const float4*)g)[tid]; float4 o;
    if (sh) { float4 s1 = ((const float4*)(sc + (size_t)b * 6 * D))[tid], s0 = ((const float4*)(sh + (size_t)b * 6 * D))[tid];
        o.x = v.x * r * gg.x * (1.f + s1.x) + s0.x; o.y = v.y * r * gg.y * (1.f + s1.y) + s0.y; o.z = v.z * r * gg.z * (1.f + s1.z) + s0.z; o.w = v.w * r * gg.w * (1.f + s1.w) + s0.w;
    } else { o.x = v.x * r * gg.x; o.y = v.y * r * gg.y; o.z = v.z * r * gg.z; o.w = v.w * r * gg.w; }
    ((float4*)(h + (size_t)t * D))[tid] = o;
}
__global__ void k_rope(float* __restrict__ proj, const float* __restrict__ cs) {
    size_t i = (size_t)blockIdx.x * blockDim.x + threadIdx.x; if (i >= (size_t)T * 2 * 12 * 8) return;
    int j = i % 8; size_t r = i / 8; int hd = r % 12; r /= 12; int which = r % 2; int t = (int)(r / 2); int s = t % S;
    float* p = proj + (size_t)t * IN_COLS + (which ? KOFF : QOFF) + hd * 64;
    float c = cs[s * 16 + j], sn = cs[s * 16 + 8 + j]; float t1 = p[j], t2 = p[j + 8];
    p[j] = t1 * c - t2 * sn; p[j + 8] = t2 * c + t1 * sn;
}
__global__ void k_attn(const float* __restrict__ proj, float* __restrict__ outg, float* __restrict__ lse) {
    const int wid = threadIdx.x >> 6, lane = threadIdx.x & 63;
    const size_t item = (size_t)blockIdx.x * 4 + wid; const int gh = item % 12; const int t = (int)(item / 12);
    const int g = gh / 4; const int dil = (g == 0) ? 1 : (g == 1 ? 4 : 16); const int b = t / S, s = t % S;
    __shared__ float qs[4][64]; __shared__ float ps[4][192];
    qs[wid][lane] = proj[(size_t)t * IN_COLS + QOFF + gh * 64 + lane];
    __syncthreads();
    float sc[3]; float mx = -3.0e38f;
#pragma unroll
    for (int p = 0; p < 3; ++p) {
        int j = p * 64 + lane - 64; int kp = s + j * dil; bool valid = (j <= 64) && kp >= 0 && kp < S; float a = -1e30f;
        if (valid) { const float* kr = proj + (size_t)(b * S + kp) * IN_COLS + KOFF + gh * 64; float acc = 0.f; for (int d = 0; d < 64; ++d) acc += qs[wid][d] * kr[d]; a = acc * 0.125f; }
        sc[p] = a; mx = fmaxf(mx, a);
    }
    mx = wmax(mx); float sum = 0.f;
#pragma unroll
    for (int p = 0; p < 3; ++p) { float e = (sc[p] > -1e29f) ? expf(sc[p] - mx) : 0.f; sc[p] = e; sum += e; }
    sum = wsum(sum);
#pragma unroll
    for (int p = 0; p < 3; ++p) ps[wid][p * 64 + lane] = sc[p];
    __syncthreads();
    float acc = 0.f;
    for (int jj = 0; jj < 129; ++jj) { int kp = s + (jj - 64) * dil; if (kp >= 0 && kp < S) acc += ps[wid][jj] * proj[(size_t)(b * S + kp) * IN_COLS + VOFF + gh * 64 + lane]; }
    outg[(size_t)t * 768 + gh * 64 + lane] = acc / sum;
    if (lane == 0) lse[(size_t)t * 12 + gh] = mx + logf(sum);
}
__global__ void k_attn_combine(const float* __restrict__ outg, const float* __restrict__ lse, float* __restrict__ attn) {
    size_t i = (size_t)blockIdx.x * blockDim.x + threadIdx.x; if (i >= (size_t)T * 256) return;
    int c = i % 256; int t = (int)(i / 256); int h = c / 64, d = c % 64;
    float l0 = lse[(size_t)t * 12 + h], l1 = lse[(size_t)t * 12 + 4 + h], l2 = lse[(size_t)t * 12 + 8 + h];
    float m = fmaxf(l0, fmaxf(l1, l2)); float e0 = expf(l0 - m), e1 = expf(l1 - m), e2 = expf(l2 - m), inv = 1.f / (e0 + e1 + e2);
    attn[i] = (e0 * outg[(size_t)t * 768 + h * 64 + d] + e1 * outg[(size_t)t * 768 + (4 + h) * 64 + d] + e2 * outg[(size_t)t * 768 + (8 + h) * 64 + d]) * inv;
}
__global__ void k_pool_diff(const float* __restrict__ proj, float* __restrict__ pd) {
    size_t i = (size_t)blockIdx.x * blockDim.x + threadIdx.x; if (i >= (size_t)T * 512) return;
    int c = i % 512; int t = (int)(i / 512); int g = c / 128; int half = 1 << g; int b = t / S, s = t % S;
    int lo = max(s - half, 0), hi = min(s + half, S); float sum = 0.f;
    for (int p = lo; p < hi; ++p) sum += proj[(size_t)(b * S + p) * IN_COLS + UOFF + c];
    pd[i] = sum / (float)(hi - lo) - proj[(size_t)t * IN_COLS + UOFF + c];
}
__global__ void k_pool_lin(const float* __restrict__ pd, const float* __restrict__ pw, const float* __restrict__ scale, float* __restrict__ py) {
    __shared__ float row[512]; const int t = blockIdx.x;
    for (int i = threadIdx.x; i < 512; i += 256) row[i] = pd[(size_t)t * 512 + i];
    __syncthreads();
    for (int o = threadIdx.x; o < 512; o += 256) { int g = o / 128, d = o % 128; float acc = 0.f; for (int c = 0; c < 128; ++c) acc += row[g * 128 + c] * pw[((size_t)g * 128 + c) * 128 + d]; py[(size_t)t * 512 + o] = acc * scale[o]; }
}
__global__ void k_merge(const float* __restrict__ proj, const float* __restrict__ aa, const float* __restrict__ pp, float* __restrict__ merged) {
    size_t i = (size_t)blockIdx.x * blockDim.x + threadIdx.x; if (i >= (size_t)T * D) return;
    int c = i % D; size_t t = i / D; float ga = proj[t * IN_COLS + GAOFF + c], gp = proj[t * IN_COLS + GPOFF + c];
    merged[i] = aa[i] / (1.f + expf(-ga)) + pp[i] / (1.f + expf(-gp));
}
__global__ void k_resid(float* __restrict__ x, const float* __restrict__ y, const float* __restrict__ gate) {
    size_t i = (size_t)blockIdx.x * blockDim.x + threadIdx.x; if (i >= (size_t)T * D) return;
    int c = i % D; int t = (int)(i / D); int b = t / S; x[i] += gate[(size_t)b * 6 * D + c] * y[i];
}
__global__ void __launch_bounds__(256) k_sgemm(const float* __restrict__ A, int lda, const int* __restrict__ ridx, const float* __restrict__ B, int ldb, size_t strideB,
                                                const float* __restrict__ bias, size_t strideBias, const int* __restrict__ tile_exp, float* __restrict__ C, int ldc, int K) {
    __shared__ float As[8][128 + 4]; __shared__ float Bs[8][128 + 4];
    const int tid = threadIdx.x, tm = blockIdx.y, tn = blockIdx.x; int e = 0;
    if (tile_exp) { e = tile_exp[tm]; if (e < 0) return; }
    const float* Bp = B + (size_t)e * strideB + (size_t)tn * 128;
    const int arow = tid >> 1, ak = (tid & 1) * 4; const int grow = tm * 128 + arow;
    const float* Ap = A + (size_t)(ridx ? ridx[grow] : grow) * lda + ak;
    const int bk = tid >> 5, bc = (tid & 31) * 4; const int ty = tid >> 4, tx = tid & 15;
    float acc[8][8];
#pragma unroll
    for (int i = 0; i < 8; ++i)
#pragma unroll
        for (int j = 0; j < 8; ++j) acc[i][j] = 0.f;
    for (int k0 = 0; k0 < K; k0 += 8) {
        float4 av = *(const float4*)(Ap + k0); float4 bv = *(const float4*)(Bp + (size_t)(k0 + bk) * ldb + bc);
        __syncthreads();
        As[ak + 0][arow] = av.x; As[ak + 1][arow] = av.y; As[ak + 2][arow] = av.z; As[ak + 3][arow] = av.w; *(float4*)&Bs[bk][bc] = bv;
        __syncthreads();
#pragma unroll
        for (int kk = 0; kk < 8; ++kk) {
            float a[8], b[8];
            *(float4*)&a[0] = *(const float4*)&As[kk][ty * 4]; *(float4*)&a[4] = *(const float4*)&As[kk][64 + ty * 4];
            *(float4*)&b[0] = *(const float4*)&Bs[kk][tx * 4]; *(float4*)&b[4] = *(const float4*)&Bs[kk][64 + tx * 4];
#pragma unroll
            for (int i = 0; i < 8; ++i)
#pragma unroll
                for (int j = 0; j < 8; ++j) acc[i][j] += a[i] * b[j];
        }
    }
    const float* bp = bias ? bias + (size_t)e * strideBias + tn * 128 : nullptr;
#pragma unroll
    for (int i = 0; i < 8; ++i) {
        int r = tm * 128 + (i < 4 ? ty * 4 + i : 64 + ty * 4 + i - 4);
#pragma unroll
        for (int jh = 0; jh < 2; ++jh) { int cc = jh * 64 + tx * 4;
            float4 o = make_float4(acc[i][jh * 4 + 0], acc[i][jh * 4 + 1], acc[i][jh * 4 + 2], acc[i][jh * 4 + 3]);
            if (bp) { o.x += bp[cc]; o.y += bp[cc + 1]; o.z += bp[cc + 2]; o.w += bp[cc + 3]; }
            *(float4*)(C + (size_t)r * ldc + tn * 128 + cc) = o; }
    }
}
__global__ void k_router(const float* __restrict__ h, const float* __restrict__ rw, const float* __restrict__ rb, int* __restrict__ top_e, float* __restrict__ top_g) {
    const int wid = threadIdx.x >> 6, lane = threadIdx.x & 63; const int t = blockIdx.x * 4 + wid; const int e = lane & 31, half = lane >> 5;
    const float* hr = h + (size_t)t * D + half * 512; const float* w = rw + (size_t)(half * 512) * NE + e;
    float acc = 0.f; for (int k = 0; k < 512; ++k) acc += hr[k] * w[(size_t)k * NE];
    acc += __shfl_xor(acc, 32); float logit = acc + rb[e];
    float vals[4]; int idx[4]; float cur = logit;
#pragma unroll
    for (int k = 0; k < 4; ++k) { float m = cur; int mi = e;
#pragma unroll
        for (int o = 16; o > 0; o >>= 1) { float om = __shfl_xor(m, o); int oi = __shfl_xor(mi, o); if (om > m || (om == m && oi < mi)) { m = om; mi = oi; } }
        vals[k] = m; idx[k] = mi; if (e == mi) cur = -3.0e38f; }
    float e0 = 1.f, e1 = expf(vals[1] - vals[0]), e2 = expf(vals[2] - vals[0]), e3 = expf(vals[3] - vals[0]); float inv = 1.f / (e0 + e1 + e2 + e3);
    if (lane == 0) { top_e[t * 4 + 0] = idx[0]; top_e[t * 4 + 1] = idx[1]; top_e[t * 4 + 2] = idx[2]; top_e[t * 4 + 3] = idx[3];
        top_g[t * 4 + 0] = e0 * inv; top_g[t * 4 + 1] = e1 * inv; top_g[t * 4 + 2] = e2 * inv; top_g[t * 4 + 3] = e3 * inv; }
}
__global__ void __launch_bounds__(1024) k_positions(const int* __restrict__ top_e, int* __restrict__ pos, int* __restrict__ cnt) {
    __shared__ int wsum_[16]; __shared__ int base_s;
    const int e = blockIdx.x, tid = threadIdx.x, wid = tid >> 6, lane = tid & 63;
    if (tid == 0) base_s = 0;
    __syncthreads();
    for (int a0 = 0; a0 < NASSIGN; a0 += 1024) {
        const int a = a0 + tid; const bool f = top_e[a] == e; const unsigned long long bal = __ballot(f);
        const int pre = __popcll(bal & ((1ull << lane) - 1ull));
        if (lane == 0) wsum_[wid] = __popcll(bal);
        __syncthreads();
        int off = base_s; for (int w = 0; w < wid; ++w) off += wsum_[w];
        if (f) pos[a] = off + pre;
        __syncthreads();
        if (tid == 0) { int s = 0; for (int w = 0; w < 16; ++w) s += wsum_[w]; base_s += s; }
        __syncthreads();
    }
    if (tid == 0) cnt[e] = base_s;
}
__global__ void k_assign(const int* __restrict__ top_e, const int* __restrict__ pos, const int* __restrict__ cnt, int* __restrict__ row_token, int* __restrict__ tok_row, int* __restrict__ tile_exp) {
    __shared__ int base[NE + 1];
    if (threadIdx.x == 0) { int s = 0; for (int e = 0; e < NE; ++e) { base[e] = s; s += (cnt[e] + RPAD - 1) / RPAD * RPAD; } base[NE] = s; }
    __syncthreads();
    const int i = blockIdx.x * blockDim.x + threadIdx.x;
    if (i < NASSIGN) { const int e = top_e[i]; const int row = base[e] + pos[i]; row_token[row] = i / TOPK; tok_row[i] = row; }
    if (i < NROWS_MAX) { int e = -1; for (int q = 0; q < NE; ++q) if (i >= base[q] && i < base[q + 1]) e = q;
        if (e >= 0 && i >= base[e] + cnt[e]) row_token[i] = 0;
        if ((i & 127) == 0) tile_exp[i >> 7] = e; }
}
__global__ void k_swiglu(const float* __restrict__ z, float* __restrict__ act, const int* __restrict__ tile_exp) {
    const int row = blockIdx.x; if (tile_exp[row >> 7] < 0) return;
    for (int j = threadIdx.x; j < D; j += 256) { float glu = fminf(z[(size_t)row * 2048 + j], 7.f); float lin = fminf(fmaxf(z[(size_t)row * 2048 + 1024 + j], -7.f), 7.f);
        act[(size_t)row * D + j] = glu / (1.f + expf(-1.702f * glu)) * (lin + 1.f); }
}
__global__ void k_moe_combine(float* __restrict__ x, const float* __restrict__ y, const int* __restrict__ tok_row, const float* __restrict__ top_g, const float* __restrict__ g2) {
    const int t = blockIdx.x, b = t / S, tid = threadIdx.x; float4 acc = make_float4(0.f, 0.f, 0.f, 0.f);
#pragma unroll
    for (int k = 0; k < 4; ++k) { const int row = tok_row[t * 4 + k]; const float gt = top_g[t * 4 + k]; float4 v = ((const float4*)(y + (size_t)row * D))[tid];
        acc.x += gt * v.x; acc.y += gt * v.y; acc.z += gt * v.z; acc.w += gt * v.w; }
    float4 gg = ((const float4*)(g2 + (size_t)b * 6 * D))[tid]; float4 xv = ((float4*)(x + (size_t)t * D))[tid];
    xv.x += gg.x * acc.x; xv.y += gg.y * acc.y; xv.z += gg.z * acc.z; xv.w += gg.w * acc.w; ((float4*)(x + (size_t)t * D))[tid] = xv;
}
__global__ void k_cmp(const uint4* __restrict__ a, const uint4* __restrict__ b, size_t n16, unsigned* __restrict__ cnt) {
    size_t i = (size_t)blockIdx.x * blockDim.x + threadIdx.x; const size_t st = (size_t)gridDim.x * blockDim.x; unsigned c = 0;
    for (; i < n16; i += st) { const uint4 x = a[i], y = b[i]; c += (x.x != y.x || x.y != y.y || x.z != y.z || x.w != y.w) ? 1u : 0u; }
    if (c) atomicAdd(cnt, c);
}
__global__ void k_emit(float* __restrict__ out, const unsigned* __restrict__ cnt, int n, size_t total) {
    float v = 0.f; for (int p = n - 1; p >= 0; --p) if (cnt[p] != 0u) v = (float)(p + 1);
    size_t i = (size_t)blockIdx.x * blockDim.x + threadIdx.x; const size_t st = (size_t)gridDim.x * blockDim.x;
    for (; i < total; i += st) out[i] = v;
}
__global__ void k_fp(const float* __restrict__ x, size_t n, double* __restrict__ fp) {
    __shared__ double red[3][256];
    double s1 = 0, s2 = 0, s3 = 0; size_t i = (size_t)blockIdx.x * blockDim.x + threadIdx.x; const size_t st = (size_t)gridDim.x * blockDim.x;
    for (; i < n; i += st) { const double v = (double)x[i]; s1 += v; s2 += v * v; s3 += v * (double)(((unsigned)i * 2654435761u >> 8) & 0xffffu) * (1.0 / 65536.0); }
    red[0][threadIdx.x] = s1; red[1][threadIdx.x] = s2; red[2][threadIdx.x] = s3; __syncthreads();
    for (int o = 128; o > 0; o >>= 1) { if ((int)threadIdx.x < o) { red[0][threadIdx.x] += red[0][threadIdx.x + o]; red[1][threadIdx.x] += red[1][threadIdx.x + o]; red[2][threadIdx.x] += red[2][threadIdx.x + o]; } __syncthreads(); }
    if (threadIdx.x == 0) { atomicAdd(fp + 0, red[0][0]); atomicAdd(fp + 1, red[1][0]); atomicAdd(fp + 2, red[2][0]); }
}
__global__ void k_relerr(const unsigned short* __restrict__ b, int ldb, const float* __restrict__ ref, int ldr, int ncols, double* __restrict__ acc2) {
    __shared__ double red[2][256];
    double d2 = 0, r2 = 0; const size_t n = (size_t)T * ncols; size_t i = (size_t)blockIdx.x * blockDim.x + threadIdx.x; const size_t st = (size_t)gridDim.x * blockDim.x;
    for (; i < n; i += st) { const size_t t = i / ncols; const int c = (int)(i % ncols); const float bv = __builtin_bit_cast(float, (unsigned)b[t * ldb + c] << 16), rv = ref[t * ldr + c]; d2 += (double)(bv - rv) * (bv - rv); r2 += (double)rv * rv; }
    red[0][threadIdx.x] = d2; red[1][threadIdx.x] = r2; __syncthreads();
    for (int o = 128; o > 0; o >>= 1) { if ((int)threadIdx.x < o) { red[0][threadIdx.x] += red[0][threadIdx.x + o]; red[1][threadIdx.x] += red[1][threadIdx.x + o]; } __syncthreads(); }
    if (threadIdx.x == 0) { atomicAdd(acc2, red[0][0]); atomicAdd(acc2 + 1, red[1][0]); }
}
__global__ void k_emit_err(float* __restrict__ out, const double* __restrict__ acc, size_t total) {
    const float ka = 100.f * (float)sqrt(acc[0] / acc[1]), kb = 100.f + 1000.f * (float)sqrt(acc[2] / acc[3]);
    size_t i = (size_t)blockIdx.x * blockDim.x + threadIdx.x; const size_t st = (size_t)gridDim.x * blockDim.x;
    for (; i < total; i += st) out[i] = (i == 0) ? kb : ka;
}
__global__ void k_rowfp(const float* __restrict__ x, double* __restrict__ fp  , const double* __restrict__ ref  , unsigned* __restrict__ cnt) {
    const int t = blockIdx.x * 4 + (threadIdx.x >> 6), lane = threadIdx.x & 63; double s2 = 0, s3 = 0;
    for (int j = lane; j < D; j += 64) { const double v = (double)x[(size_t)t * D + j]; s2 += v * v; s3 += v * (double)((j * 37 + 11) % 64 + 1); }
    for (int o = 32; o > 0; o >>= 1) { s2 += __shfl_xor(s2, o); s3 += __shfl_xor(s3, o); }
    if (lane == 0) {
        if (!ref) { fp[t * 2] = s2; fp[t * 2 + 1] = s3; }
        else { const double a2 = ref[t * 2], a3 = ref[t * 2 + 1]; const bool bad = !(fabs(a2 - s2) <= 1e-5 * (fabs(a2) + fabs(s2))) || !(fabs(a3 - s3) <= 1e-5 * sqrt(fabs(a2) + fabs(s2)) * 40.0); if (bad) atomicAdd(cnt, 1u); }
    }
}
__global__ void k_emit3(float* __restrict__ out, const unsigned* __restrict__ cnt, int nchk, size_t total) {
    float v = 0.f;
    for (int c = nchk - 1; c >= 0; --c) if (cnt[c] != 0u) v = (float)(c + 1) + (cnt[c] < 32u ? 0.f : (cnt[c] < 3277u ? 0.3f : 0.6f));
    size_t i = (size_t)blockIdx.x * blockDim.x + threadIdx.x; const size_t st = (size_t)gridDim.x * blockDim.x;
    for (; i < total; i += st) out[i] = v;
}
__global__ void k_emit2(float* __restrict__ out, const double* __restrict__ fp, int nchk, size_t total) {
    float v = 0.f;
    for (int c = nchk - 1; c >= 0; --c) { bool bad = false;
        for (int q = 0; q < 3; ++q) { const double a = fp[c * 3 + q], b = fp[(nchk + c) * 3 + q]; const double d = fabs(a - b), m = fabs(a) + fabs(b) + 1e-30; if (!(d <= 1e-7 * m)) bad = true; }
        if (bad) v = (float)(c + 1); }
    size_t i = (size_t)blockIdx.x * blockDim.x + threadIdx.x; const size_t st = (size_t)gridDim.x * blockDim.x;
    for (; i < total; i += st) out[i] = v;
}
}
#endif

extern "C" void kernel_launch(void* const* d_in, const int* in_sizes, int n_in, void* d_out, int out_size, void* d_ws, size_t ws_size, hipStream_t stream) {
    using namespace mk;
    static int grid = 0;
    if (grid == 0) {
        int dev = 0, cus = 0;
        if (n_in != 19 || out_size != T * D || ws_size < WS_END) { fprintf(stderr, "kernel_launch: unexpected problem (n_in %d out %d ws %zu need %zu)\n", n_in, out_size, ws_size, (size_t)WS_END); grid = -1; return; }
        if (hipGetDevice(&dev) != hipSuccess || hipDeviceGetAttribute(&cus, hipDeviceAttributeMultiprocessorCount, dev) != hipSuccess) { grid = -1; return; }
        if (hipFuncSetAttribute((const void*)mega_fwd, hipFuncAttributeMaxDynamicSharedMemorySize, LDS_BYTES) != hipSuccess) { fprintf(stderr, "kernel_launch: hipFuncSetAttribute failed\n"); grid = -1; return; }
        int per_cu = 0;
        if (hipOccupancyMaxActiveBlocksPerMultiprocessor(&per_cu, (const void*)mega_fwd, NTHREADS, LDS_BYTES) != hipSuccess || per_cu < 1) { fprintf(stderr, "kernel_launch: occupancy query says %d\n", per_cu); (void)hipGetLastError(); }
        if (cus < GRID) { fprintf(stderr, "kernel_launch: needs %d CUs, device has %d\n", GRID, cus); grid = -1; return; }
        grid = GRID;
    }
    if (grid < 0) return;
    (void)hipMemsetAsync((char*)d_ws + WS_CTL, 0, MODE == 0 ? (size_t)(CW_BAR + BAR_REGION_WORDS) * 4 : ZERO_BYTES, stream);
#if MODE != 0
    (void)hipMemsetAsync((char*)d_ws + ZERO_BYTES, 0xFF, ws_size - ZERO_BYTES, stream);
#endif
    Args a{};
    for (int i = 0; i < 19; ++i) a.in[i] = (const float*)d_in[i];
    a.out = (float*)d_out; a.ws = (unsigned char*)d_ws;
    int li = 0;
    auto launch = [&](int lo, int hi, int flags) { a.ph_lo = lo; a.ph_hi = hi; a.li = li++; a.flags = flags; hipLaunchKernelGGL(mega_fwd, dim3(grid), dim3(NTHREADS), LDS_BYTES, stream, a); };
#if MODE == 0
    launch(0, NPHASE, 0);
#elif MODE == 3
    for (int p = 0; p < NPHASE; ++p) launch(p, p + 1, 0);
#elif MODE == 7
    {
        using namespace nv;
        const float* x_in = (const float*)d_in[0]; char* ws = (char*)d_ws; size_t off = WS_END;
        auto carve = [&](size_t bytes) { char* p = ws + off; off += (bytes + 255) & ~(size_t)255; return p; };
        float* h = (float*)carve((size_t)T * D * 4); float* mod = (float*)carve((size_t)DEPTH * NB * 6 * D * 4); float* ropecs = (float*)carve((size_t)S * 16 * 4);
        float* proj = (float*)carve((size_t)T * IN_COLS * 4); float* outg = (float*)carve((size_t)T * 768 * 4); float* lse = (float*)carve((size_t)T * 12 * 4);
        float* attn = (float*)carve((size_t)T * 256 * 4); float* pd = (float*)carve((size_t)T * 512 * 4);
        if (off > ws_size) { fprintf(stderr, "ws too small for probe\n"); return; }
        double* acc = (double*)(ws + WS_CTL + 8192);
        k_mod<<<dim3(6 * D / 256, DEPTH), 256, 0, stream>>>((const float*)d_in[1], (const float*)d_in[2], (const float*)d_in[3], mod);
        k_rope_table<<<(S * 8 + 255) / 256, 256, 0, stream>>>(ropecs);
        k_norm_mod<<<T, 256, 0, stream>>>(x_in, (const float*)d_in[4], mod + 0 * D, mod + 1 * D, h);
        k_sgemm<<<dim3(IN_COLS / 128, T / 128), 256, 0, stream>>>(h, D, nullptr, (const float*)d_in[5], IN_COLS, 0, nullptr, 0, nullptr, proj, IN_COLS, D);
        k_rope<<<(unsigned)(((size_t)T * 2 * 12 * 8 + 255) / 256), 256, 0, stream>>>(proj, ropecs);
        k_attn<<<T * 12 / 4, 256, 0, stream>>>(proj, outg, lse);
        k_attn_combine<<<(unsigned)(((size_t)T * 256 + 255) / 256), 256, 0, stream>>>(outg, lse, attn);
        k_pool_diff<<<(unsigned)(((size_t)T * 512 + 255) / 256), 256, 0, stream>>>(proj, pd);
        launch(0, 1, 0);
        for (int p = 1; p <= 4; ++p) launch(p, p + 1, 0);
        k_relerr<<<2048, 256, 0, stream>>>((const unsigned short*)(ws + WS_AD), 768, attn, 256, 256, acc);
        k_relerr<<<2048, 256, 0, stream>>>((const unsigned short*)(ws + WS_AD) + 256, 768, pd, 512, 512, acc + 2);
        k_emit_err<<<2048, 256, 0, stream>>>((float*)d_out, acc, (size_t)T * D);
    }
#elif MODE == 5
    {
        using namespace nv;
        char* ws = (char*)d_ws; unsigned* cnt = (unsigned*)(ws + WS_CTL) + 1024;
        const size_t nx = (size_t)T * D;
        struct Reg { size_t off, bytes; };
        const Reg regs[7] = {{WS_H, (size_t)T * D * 2}, {WS_Q, WS_OG - WS_Q}, {WS_OG, WS_AD - WS_OG}, {WS_AD, (size_t)T * 768 * 2}, {WS_MA, (size_t)T * D * 2}, {WS_MG, (size_t)T * D * 2}, {WS_X, (size_t)T * D * 4}};
        size_t snap[7]; size_t o = WS_END; for (int p = 0; p < 7; ++p) { snap[p] = o; o += (regs[p].bytes + 4095) & ~(size_t)4095; }
        if (o > ws_size) { fprintf(stderr, "ws too small for probe\n"); return; }
        for (int run = 0; run < 2; ++run) {
            if (run == 1) { (void)hipMemsetAsync(ws + WS_MOD, 0, MOD_BYTES, stream); (void)hipMemsetAsync(ws + ZERO_BYTES, 0x55, WS_END - ZERO_BYTES, stream); }
            launch(0, 1, 0);
            k_copy<<<(unsigned)((nx / 4 + 255) / 256), 256, 0, stream>>>((const float*)d_in[0], (float*)(ws + WS_X), nx / 4);
            for (int p = 0; p < 7; ++p) {
                launch(1 + p, 2 + p, 1 | (run ? 16 : 0));
                if (run == 0) (void)hipMemcpyAsync(ws + snap[p], ws + regs[p].off, regs[p].bytes, hipMemcpyDeviceToDevice, stream);
                else k_cmp<<<2048, 256, 0, stream>>>((const uint4*)(ws + snap[p]), (const uint4*)(ws + regs[p].off), regs[p].bytes / 16, cnt + p);
            }
        }
        k_emit<<<2048, 256, 0, stream>>>((float*)d_out, cnt, 7, nx);
    }
#else
    for (int run = 0; run < (MODE == 6 ? 2 : 1); ++run) {
        using namespace nv;
        const size_t fp_bytes = (size_t)9 * T * 2 * 8; double* rowfp = (double*)((char*)d_ws + ws_size - fp_bytes); unsigned* rcnt = (unsigned*)((char*)d_ws + WS_CTL + 8192);
        if (run == 1) { (void)hipMemsetAsync((char*)d_ws + WS_MOD, 0, MOD_BYTES, stream); (void)hipMemsetAsync((char*)d_ws + ZERO_BYTES, 0x55, ws_size - ZERO_BYTES - fp_bytes, stream); }
        const float* x_in = (const float*)d_in[0]; const float* c = (const float*)d_in[1]; const float* ada_w = (const float*)d_in[2]; const float* ada_b = (const float*)d_in[3];
        const float* norm1_g = (const float*)d_in[4]; const float* w_in = (const float*)d_in[5]; const float* pool_w = (const float*)d_in[6]; const float* pool_scale = (const float*)d_in[7];
        const float* w_ab = (const float*)d_in[8]; const float* w_pb = (const float*)d_in[9]; const float* w_out = (const float*)d_in[10]; const float* norm2_g = (const float*)d_in[11];
        const float* router_w = (const float*)d_in[12]; const float* router_b = (const float*)d_in[13]; const float* w_gu = (const float*)d_in[14]; const float* b_gu = (const float*)d_in[15];
        const float* w_down = (const float*)d_in[16]; const float* b_down = (const float*)d_in[17]; const float* final_g = (const float*)d_in[18];
        float* out = (float*)d_out;
        char* ws = (char*)d_ws; size_t off = WS_ACT;
        auto carve = [&](size_t bytes) { char* p = ws + off; off += (bytes + 255) & ~(size_t)255; return p; };
        char* actr = carve((size_t)NROWS_MAX * D * 4);
        if (off < WS_END) off = WS_END;
        float* x = (float*)(ws + WS_X);
        float* h = (float*)carve((size_t)T * D * 4);
        float* mod = (float*)carve((size_t)DEPTH * NB * 6 * D * 4);
        float* ropecs = (float*)carve((size_t)S * 16 * 4);
        int* top_e = (int*)carve((size_t)NASSIGN * 4); float* top_g = (float*)carve((size_t)NASSIGN * 4);
        int* pos = (int*)carve((size_t)NASSIGN * 4); int* cnt = (int*)carve(256);
        int* row_token = (int*)carve((size_t)NROWS_MAX * 4); int* tok_row = (int*)carve((size_t)NASSIGN * 4); int* tile_exp = (int*)carve((size_t)(NROWS_MAX / 128) * 4);
        char* big = carve((size_t)NROWS_MAX * 2048 * 4);
        float* y = (float*)carve((size_t)NROWS_MAX * D * 4);
        float* z = (float*)big;
        float* proj = (float*)big; float* outg = proj + (size_t)T * IN_COLS; float* Aa = outg + (size_t)T * 768; float* Pp = Aa + (size_t)T * D;
        float* act = (float*)actr;
        float* merged = (float*)actr; float* mo = merged + (size_t)T * D; float* attn = mo + (size_t)T * D; float* pd = attn + (size_t)T * 256; float* py = pd + (size_t)T * 512; float* lse = py + (size_t)T * 512;
        if (off > ws_size) { fprintf(stderr, "ws too small: need %zu have %zu\n", off, ws_size); return; }
        const size_t nx = (size_t)T * D;
        k_copy<<<(unsigned)((nx / 4 + 255) / 256), 256, 0, stream>>>(x_in, x, nx / 4);
        k_mod<<<dim3(6 * D / 256, DEPTH), 256, 0, stream>>>(c, ada_w, ada_b, mod);
        k_rope_table<<<(S * 8 + 255) / 256, 256, 0, stream>>>(ropecs);
        launch(0, 1, 0);
        for (int l = 0; l < DEPTH; ++l) {
            const float* ml = mod + (size_t)l * NB * 6 * D;
            const int pb = 1 + l * PH_PER_LAYER;
            if (MODE == 1) {
                launch(pb, pb + 7, 1);
            } else if (MODE == 4 || MODE == 6) {
                for (int p = pb; p < pb + 7; ++p) launch(p, p + 1, 1);
            } else {
                k_norm_mod<<<T, 256, 0, stream>>>(x, norm1_g + l * D, ml + 0 * D, ml + 1 * D, h);
                k_sgemm<<<dim3(IN_COLS / 128, T / 128), 256, 0, stream>>>(h, D, nullptr, w_in + (size_t)l * D * IN_COLS, IN_COLS, 0, nullptr, 0, nullptr, proj, IN_COLS, D);
                k_rope<<<(unsigned)(((size_t)T * 2 * 12 * 8 + 255) / 256), 256, 0, stream>>>(proj, ropecs);
                k_attn<<<T * 12 / 4, 256, 0, stream>>>(proj, outg, lse);
                k_attn_combine<<<(unsigned)(((size_t)T * 256 + 255) / 256), 256, 0, stream>>>(outg, lse, attn);
                k_pool_diff<<<(unsigned)(((size_t)T * 512 + 255) / 256), 256, 0, stream>>>(proj, pd);
                k_pool_lin<<<T, 256, 0, stream>>>(pd, pool_w + (size_t)l * 4 * 128 * 128, pool_scale + l * 512, py);
                k_sgemm<<<dim3(D / 128, T / 128), 256, 0, stream>>>(attn, 256, nullptr, w_ab + (size_t)l * 256 * D, D, 0, nullptr, 0, nullptr, Aa, D, 256);
                k_sgemm<<<dim3(D / 128, T / 128), 256, 0, stream>>>(py, 512, nullptr, w_pb + (size_t)l * 512 * D, D, 0, nullptr, 0, nullptr, Pp, D, 512);
                k_merge<<<(unsigned)((nx + 255) / 256), 256, 0, stream>>>(proj, Aa, Pp, merged);
                k_sgemm<<<dim3(D / 128, T / 128), 256, 0, stream>>>(merged, D, nullptr, w_out + (size_t)l * D * D, D, 0, nullptr, 0, nullptr, mo, D, D);
                k_resid<<<(unsigned)((nx + 255) / 256), 256, 0, stream>>>(x, mo, ml + 2 * D);
            }
            if (MODE == 6) k_rowfp<<<T / 4, 256, 0, stream>>>(x, rowfp + (size_t)(2 * l) * T * 2, run ? rowfp + (size_t)(2 * l) * T * 2 : nullptr, rcnt + 2 * l);
            if (MODE == 2) {
                launch(pb + 7, pb + 11, 0);
                launch(PH_FINAL, PH_FINAL + 1, 2 | (l << 8));
            } else {
                k_norm_mod<<<T, 256, 0, stream>>>(x, norm2_g + l * D, ml + 3 * D, ml + 4 * D, h);
                k_router<<<T / 4, 256, 0, stream>>>(h, router_w + (size_t)l * D * NE, router_b + l * NE, top_e, top_g);
                k_positions<<<NE, 1024, 0, stream>>>(top_e, pos, cnt);
                k_assign<<<(NROWS_MAX + 255) / 256, 256, 0, stream>>>(top_e, pos, cnt, row_token, tok_row, tile_exp);
                k_sgemm<<<dim3(2048 / 128, NROWS_MAX / 128), 256, 0, stream>>>(h, D, row_token, w_gu + (size_t)l * NE * D * 2048, 2048, (size_t)D * 2048, b_gu + (size_t)l * NE * 2048, 2048, tile_exp, z, 2048, D);
                k_swiglu<<<NROWS_MAX, 256, 0, stream>>>(z, act, tile_exp);
                k_sgemm<<<dim3(D / 128, NROWS_MAX / 128), 256, 0, stream>>>(act, D, nullptr, w_down + (size_t)l * NE * D * D, D, (size_t)D * D, b_down + (size_t)l * NE * D, D, tile_exp, y, D, D);
                k_moe_combine<<<T, 256, 0, stream>>>(x, y, tok_row, top_g, ml + 5 * D);
            }
            if (MODE == 6) k_rowfp<<<T / 4, 256, 0, stream>>>(x, rowfp + (size_t)(2 * l + 1) * T * 2, run ? rowfp + (size_t)(2 * l + 1) * T * 2 : nullptr, rcnt + 2 * l + 1);
        }
        k_norm_mod<<<T, 256, 0, stream>>>(x, final_g, nullptr, nullptr, out);
        if (MODE == 6) { k_rowfp<<<T / 4, 256, 0, stream>>>(out, rowfp + (size_t)8 * T * 2, run ? rowfp + (size_t)8 * T * 2 : nullptr, rcnt + 8); if (run == 1) k_emit3<<<2048, 256, 0, stream>>>(out, rcnt, 9, nx); }
    }
#endif
}
```

```cpp
#include <hip/hip_runtime.h>
#include <cstdint>
#include <cstdio>

#ifndef MODE
#define MODE 0
#endif

#ifndef DUP_K
#define DUP_K (-1)
#endif
#ifndef X_BF16
#define X_BF16 1
#endif
#ifndef TAIL_B
#define TAIL_B 3
#define TAIL_J 1
#define TAIL_K 2
#endif
#ifndef MOE_FP8
#define MOE_FP8 1
#ifndef P16_MASK
#define P16_MASK 31
#endif
#ifndef DRAIN_STATIC
#define DRAIN_STATIC 0
#endif
#define Y_FP8 1
#define GATE_U8 1
#define G_FP8 1
#define B_FP8 1
#endif
#define REP(k) _Pragma("unroll 1") for (int rep_ = 0, nrep_ = ((DUP_K == (k)) ? mk::opaque_s(2) : 1); rep_ < nrep_; ++rep_)
#define LAS __attribute__((address_space(3)))
#define GAS __attribute__((address_space(1)))

namespace mk {
constexpr int D = 1024, NB = 16, S = 2048, T = NB * S, DEPTH = 4;
constexpr int IN_COLS = 4864;
constexpr int NE = 32, TOPK = 4, NASSIGN = T * TOPK, RPAD = 256, NROWS_MAX = NASSIGN + NE * RPAD;
constexpr float EPS = 1e-5f;
constexpr float YSCALE = 32.f;
constexpr float HSCALE = 16.f, WSCALE = 256.f, ASCALE = 8.f;
constexpr int EB = MOE_FP8 ? 1 : 2;
constexpr int NWAVES = 8, NTHREADS = 512, GRID = 256, TPB = T / GRID;

typedef unsigned short bf16;
typedef short bf16x8 __attribute__((ext_vector_type(8)));
typedef short s16x4 __attribute__((ext_vector_type(4)));
typedef float f32x2 __attribute__((ext_vector_type(2)));
typedef float f32x4 __attribute__((ext_vector_type(4)));
typedef float f32x16 __attribute__((ext_vector_type(16)));
typedef unsigned u32x2 __attribute__((ext_vector_type(2)));
typedef unsigned u32x4 __attribute__((ext_vector_type(4)));
typedef __bf16 bf16x2_t __attribute__((ext_vector_type(2)));

__device__ __forceinline__ unsigned pk2(float lo, float hi) { f32x2 v = {lo, hi}; bf16x2_t b = __builtin_convertvector(v, bf16x2_t); return __builtin_bit_cast(unsigned, b); }
__device__ __forceinline__ int opaque_s(int v);
#define KF(x) __builtin_bit_cast(float, mk::opaque_s(__builtin_bit_cast(int, (float)(x))))
__device__ __forceinline__ float fexp(float x) { return __builtin_amdgcn_exp2f(x * KF(1.4426950408889634f)); }
__device__ __forceinline__ float flog(float x) { return __builtin_amdgcn_logf(x) * KF(0.6931471805599453f); }
template <bool CLAMP = true>
__device__ __forceinline__ unsigned pk4_fp8(float a, float b, float c, float d) {
    if (CLAMP) { const float hi = KF(448.f), lo = -hi; a = fminf(fmaxf(a, lo), hi); b = fminf(fmaxf(b, lo), hi); c = fminf(fmaxf(c, lo), hi); d = fminf(fmaxf(d, lo), hi); }
    int p = 0; p = __builtin_amdgcn_cvt_pk_fp8_f32(a, b, p, false); p = __builtin_amdgcn_cvt_pk_fp8_f32(c, d, p, true); return (unsigned)p; }
__device__ __forceinline__ float bflo(unsigned u) { return __builtin_bit_cast(float, u << 16); }
__device__ __forceinline__ float bfhi(unsigned u) { return __builtin_bit_cast(float, u & 0xffff0000u); }
__device__ __forceinline__ float fsigmoid(float x) { return __builtin_amdgcn_rcpf(1.f + __builtin_amdgcn_exp2f(-1.4426950408889634f * x)); }
__device__ __forceinline__ int lane_id() { int l; asm volatile("v_mbcnt_lo_u32_b32 %0, -1, 0\n\tv_mbcnt_hi_u32_b32 %0, -1, %0" : "=v"(l)); return l; }
__device__ __forceinline__ int opaque_s(int v) { asm volatile("" : "+s"(v)); return v; }
__device__ __forceinline__ int opaque(int v) { asm volatile("" : "+v"(v)); return v; }
__device__ __forceinline__ f32x4 xload4(const void* X, size_t idx, bool f32src) {
    if (f32src || !X_BF16) return *(const f32x4*)((const float*)X + idx);
    const u32x2 w = *(const u32x2*)((const unsigned short*)X + idx); return (f32x4){bflo(w.x), bfhi(w.x), bflo(w.y), bfhi(w.y)};
}
__device__ __forceinline__ void xstore4(void* X, size_t idx, const f32x4 v) {
    if (!X_BF16) { *(f32x4*)((float*)X + idx) = v; return; }
    u32x2 w; w.x = pk2(v[0], v[1]); w.y = pk2(v[2], v[3]); *(u32x2*)((unsigned short*)X + idx) = w;
}
__device__ __forceinline__ float wave_sum(float v) {
#pragma unroll
    for (int o = 1; o < 64; o <<= 1) v += __shfl_xor(v, o);
    return v;
}

constexpr int BM = 256, BK = 64, HALF = 128, HTB = HALF * BK * 2, STAGE_BYTES = 8 * HTB, NXCD = 8, WGM = 8;
__host__ __device__ __forceinline__ int lds_byte(int r, int c) { const int st = (r >> 4) * 2 + (c >> 5), rr = r & 15, cc = c & 31, ob = rr * 64 + cc * 2; return st * 1024 + (ob ^ (((ob >> 9) & 1) << 5)); }
__host__ __device__ __forceinline__ void stage_rc(int b, int& R, int& C) { const int st = b / 1024, sb = b % 1024, swz = sb ^ (((sb >> 9) & 1) << 5); R = (st >> 1) * 16 + swz / 64; C = (st & 1) * 32 + (swz % 64) / 2; }
__host__ __device__ __forceinline__ int perm32(int rho) { const int n = rho >> 4, i = rho & 15; return 8 * (i >> 2) + 4 * n + (i & 3); }

struct Unit { int pm, pn, e; };
struct StaticOrder {
    int nM, nN, nwg, G, c, wgm; bool colfast;
    __device__ void init(int nM_, int nN_, int G_, int c_, bool colfast_ = false, int wgm_ = WGM) { nM = nM_; nN = nN_; nwg = nM * nN; G = G_; c = c_; colfast = colfast_; wgm = wgm_; }
    __device__ bool next(int i, Unit& u) const {
        const long L = (long)i * G + c; if (L >= nwg) return false;
        int wgid = (int)L; { const int q = nwg / NXCD, r = nwg % NXCD, xcd = wgid % NXCD, off = wgid / NXCD; wgid = (xcd < r ? xcd * (q + 1) : r * (q + 1) + (xcd - r) * q) + off; }
        const int nig = wgm * nN, gid = wgid / nig, fm = gid * wgm, gsz = (nM - fm) < wgm ? (nM - fm) : wgm;
        const int w = wgid % nig;
        if (colfast) { u.pm = fm + w / nN; u.pn = w % nN; } else { u.pm = fm + (w % gsz); u.pn = w / gsz; }
        u.e = 0; return true;
    }
};
struct DenseSched {
    static constexpr bool GATHER = false;
    StaticOrder so; const char* A; const char* Bt; int lda, K;
    __device__ __forceinline__ bool next(int i, Unit& u) const { return so.next(i, u); }
    __device__ __forceinline__ const char* a_ptr(const Unit& u) const { return A + (size_t)u.pm * BM * lda * 2; }
    __device__ __forceinline__ const char* b_ptr(const Unit& u) const { return Bt + (size_t)u.pn * BM * K * 2; }
    __device__ __forceinline__ void a_offs(const Unit&, const int (&rowA)[2], const unsigned (&colA)[2], unsigned (&o)[2][2]) const {
#pragma unroll
        for (int h = 0; h < 2; ++h)
#pragma unroll
            for (int i = 0; i < 2; ++i) o[h][i] = (unsigned)((h * HALF + rowA[i]) * lda) * 2u + colA[i];
    }
};
template <bool GATHER_> struct MoeSched {
    static constexpr bool GATHER = GATHER_;
    StaticOrder so; const char* A; const char* Bt; int lda, K; size_t estride; const int* tile_exp; const int* row_token;
    __device__ __forceinline__ bool next(int i, Unit& u) const { if (!so.next(i, u)) return false; u.e = tile_exp[u.pm]; return true; }
    __device__ __forceinline__ const char* a_ptr(const Unit& u) const { return GATHER ? A : A + (size_t)u.pm * BM * lda * 2; }
    __device__ __forceinline__ const char* b_ptr(const Unit& u) const { return Bt + (size_t)u.e * estride + (size_t)u.pn * BM * K * 2; }
    __device__ __forceinline__ void a_offs(const Unit& u, const int (&rowA)[2], const unsigned (&colA)[2], unsigned (&o)[2][2]) const {
#pragma unroll
        for (int h = 0; h < 2; ++h)
#pragma unroll
            for (int i = 0; i < 2; ++i) {
                if (GATHER) o[h][i] = (unsigned)row_token[u.pm * BM + h * HALF + rowA[i]] * (unsigned)(lda * 2) + colA[i];
                else o[h][i] = (unsigned)((h * HALF + rowA[i]) * lda) * 2u + colA[i];
            }
    }
};

typedef f32x4 Acc[2][2][4][2];

__device__ __forceinline__ u32x4 pack8(const f32x4 v0, const f32x4 v1) { u32x4 w; w.x = pk2(v0[0], v0[1]); w.y = pk2(v0[2], v0[3]); w.z = pk2(v1[0], v1[1]); w.w = pk2(v1[2], v1[3]); return w; }
__device__ __forceinline__ void unpack8(const u32x4 w, f32x4& v0, f32x4& v1) { v0 = (f32x4){bflo(w.x), bfhi(w.x), bflo(w.y), bfhi(w.y)}; v1 = (f32x4){bflo(w.z), bfhi(w.z), bflo(w.w), bfhi(w.w)}; }

__device__ __forceinline__ unsigned pk4_u8(const f32x4 v) {
    const float s = KF(255.f); unsigned p = 0;
    p = __builtin_amdgcn_cvt_pk_u8_f32(v[0] * s, 0, p); p = __builtin_amdgcn_cvt_pk_u8_f32(v[1] * s, 1, p); p = __builtin_amdgcn_cvt_pk_u8_f32(v[2] * s, 2, p); p = __builtin_amdgcn_cvt_pk_u8_f32(v[3] * s, 3, p); return p; }
__device__ __forceinline__ f32x4 unpk4_u8(unsigned w) { const float s = KF(1.f / 255.f); return (f32x4){(float)(w & 0xffu), (float)((w >> 8) & 0xffu), (float)((w >> 16) & 0xffu), (float)(w >> 24)} * s; }
__device__ __forceinline__ void gate8(const bf16* Gt, size_t ro, f32x4& g0, f32x4& g1) {
    if (GATE_U8) { const u32x2 w = *(const u32x2*)((const unsigned char*)Gt + ro); g0 = unpk4_u8(w.x); g1 = unpk4_u8(w.y); }
    else unpack8(*(const u32x4*)(Gt + ro), g0, g1);
}
template <bool P16_> __device__ __forceinline__ void gate16(const bf16* Gt, size_t ro, int bjstep, f32x4 (&g)[2][2]) {
    if (GATE_U8 && P16_) { const u32x4 w = *(const u32x4*)((const unsigned char*)Gt + ro); g[0][0] = unpk4_u8(w.x); g[0][1] = unpk4_u8(w.y); g[1][0] = unpk4_u8(w.z); g[1][1] = unpk4_u8(w.w); }
    else { gate8(Gt, ro, g[0][0], g[0][1]); gate8(Gt, ro + bjstep, g[1][0], g[1][1]); }
}
struct EpiProj {
    static constexpr bool PERM = true, P16 = (P16_MASK & 1) != 0; static constexpr int BJ = P16 ? 8 : HALF;
    struct Pre {}; __device__ __forceinline__ void pre(const Unit&, int, Pre&) const {}
    bf16 *Q, *Kb, *V, *U, *GA, *GP; const float* rope;
    __device__ __forceinline__ void operator()(const Acc& acc, const Unit& u, int wid, const Pre& PR) const {
        const int lane_ = lane_id(), wr = wid >> 2, wc = wid & 3, fr = lane_ & 15, fq = lane_ >> 4;
        const int pn = u.pn; bf16* base; int ld, ct, kind;
        if (pn < 3) { base = Q; ld = 768; ct = pn; kind = 1; }
        else if (pn < 6) { base = Kb; ld = 768; ct = pn - 3; kind = 1; }
        else if (pn < 9) { base = V; ld = 768; ct = pn - 6; kind = 0; }
        else if (pn < 11) { base = U; ld = 512; ct = pn - 9; kind = 0; }
        else if (pn < 15) { base = GA; ld = 1024; ct = pn - 11; kind = 2; }
        else { base = GP; ld = 1024; ct = pn - 15; kind = 2; }
        const int row0 = u.pm * BM + wr * 64 + fr, col0 = ct * BM + (P16 ? wc * 64 + 16 * fq : wc * 32 + 8 * fq);
        const bool do_rope = (kind == 1) && (P16 ? (fq == 0) : (((wc & 1) == 0) && (fq < 2)));
#pragma unroll
        for (int ai = 0; ai < 2; ++ai)
#pragma unroll
            for (int m = 0; m < 4; ++m) {
                const int row = row0 + ai * HALF + m * 16;
                f32x4 csb[2], snb[2];
#pragma unroll
                for (int bj = 0; bj < 2; ++bj) { csb[bj] = (f32x4){1.f, 1.f, 1.f, 1.f}; snb[bj] = (f32x4){0.f, 0.f, 0.f, 0.f};
                    if (do_rope) { const float* rp = rope + (size_t)(row & (S - 1)) * 16 + 4 * (P16 ? bj : fq); csb[bj] = *(const f32x4*)rp; snb[bj] = *(const f32x4*)(rp + 8); } }
                bf16* rowp = base + (size_t)row * ld + col0;
                unsigned wq[4];
#pragma unroll
                for (int bj = 0; bj < 2; ++bj) {
                    f32x4 v0 = acc[ai][bj][m][0], v1 = acc[ai][bj][m][1];
                    if (B_FP8) { const float zs = KF(1.f / (HSCALE * WSCALE)); v0 = v0 * zs; v1 = v1 * zs; }
                    if (kind == 1) { const f32x4 cs = csb[bj], sn = snb[bj]; const f32x4 n0 = v0 * cs - v1 * sn, n1 = v1 * cs + v0 * sn; v0 = n0; v1 = n1; }
                    if (kind == 2) {
#pragma unroll
                        for (int e = 0; e < 4; ++e) { v0[e] = fsigmoid(v0[e]); v1[e] = fsigmoid(v1[e]); }
                    }
                    if (GATE_U8 && kind == 2) { wq[2 * bj] = pk4_u8(v0); wq[2 * bj + 1] = pk4_u8(v1);
                        if (!P16) *(u32x2*)((unsigned char*)base + (size_t)row * ld + col0 + bj * BJ) = (u32x2){wq[2 * bj], wq[2 * bj + 1]}; }
                    else *(u32x4*)(rowp + bj * BJ) = pack8(v0, v1);
                }
                if (GATE_U8 && kind == 2 && P16) *(u32x4*)((unsigned char*)base + (size_t)row * ld + col0) = (u32x4){wq[0], wq[1], wq[2], wq[3]};
            }
    }
};
struct EpiGate {
    static constexpr bool PERM = true, P16 = (P16_MASK & 2) != 0; static constexpr int BJ = P16 ? 8 : HALF;
    struct Pre {}; __device__ __forceinline__ void pre(const Unit&, int, Pre&) const {}
    const bf16* Gt; bf16* O;
    __device__ __forceinline__ void operator()(const Acc& acc, const Unit& u, int wid, const Pre& PR) const {
        const int lane_ = lane_id(), wr = wid >> 2, wc = wid & 3, fr = lane_ & 15, fq = lane_ >> 4;
        const int row0 = u.pm * BM + wr * 64 + fr, col0 = u.pn * BM + (P16 ? wc * 64 + 16 * fq : wc * 32 + 8 * fq);
#pragma unroll
        for (int ai = 0; ai < 2; ++ai)
#pragma unroll
            for (int m = 0; m < 4; ++m) {
                const size_t ro = (size_t)(row0 + ai * HALF + m * 16) * D + col0;
                f32x4 gg[2][2]; gate16<P16>(Gt, ro, BJ, gg);
#pragma unroll
                for (int bj = 0; bj < 2; ++bj) *(u32x4*)(O + ro + bj * BJ) = pack8(acc[ai][bj][m][0] * gg[bj][0], acc[ai][bj][m][1] * gg[bj][1]);
                if (m & 1) __builtin_amdgcn_sched_barrier(0);
            }
    }
};
struct EpiGateAdd {
    static constexpr bool PERM = true, P16 = (P16_MASK & 4) != 0; static constexpr int BJ = P16 ? 8 : HALF;
    struct Pre {}; __device__ __forceinline__ void pre(const Unit&, int, Pre&) const {}
    const bf16* Gt; const bf16* P; bf16* O;
    __device__ __forceinline__ void operator()(const Acc& acc, const Unit& u, int wid, const Pre& PR) const {
        const int lane_ = lane_id(), wr = wid >> 2, wc = wid & 3, fr = lane_ & 15, fq = lane_ >> 4;
        const int row0 = u.pm * BM + wr * 64 + fr, col0 = u.pn * BM + (P16 ? wc * 64 + 16 * fq : wc * 32 + 8 * fq);
#pragma unroll
        for (int ai = 0; ai < 2; ++ai)
#pragma unroll
            for (int m = 0; m < 4; ++m) {
                const size_t ro = (size_t)(row0 + ai * HALF + m * 16) * D + col0;
                unsigned wq[4]; f32x4 gg[2][2]; gate16<P16>(Gt, ro, BJ, gg);
#pragma unroll
                for (int bj = 0; bj < 2; ++bj) {
                    f32x4 p0, p1; const f32x4 g0 = gg[bj][0], g1 = gg[bj][1]; unpack8(*(const u32x4*)(P + ro + bj * BJ), p0, p1);
                    const f32x4 o0 = p0 + acc[ai][bj][m][0] * g0, o1 = p1 + acc[ai][bj][m][1] * g1;
                    if (G_FP8) { wq[2 * bj] = pk4_fp8(o0[0] * HSCALE, o0[1] * HSCALE, o0[2] * HSCALE, o0[3] * HSCALE); wq[2 * bj + 1] = pk4_fp8(o1[0] * HSCALE, o1[1] * HSCALE, o1[2] * HSCALE, o1[3] * HSCALE);
                        if (!P16) *(u32x2*)((unsigned char*)O + ro + bj * BJ) = (u32x2){wq[2 * bj], wq[2 * bj + 1]}; }
                    else *(u32x4*)(O + ro + bj * BJ) = pack8(o0, o1);
                }
                if (G_FP8 && P16) *(u32x4*)((unsigned char*)O + ro) = (u32x4){wq[0], wq[1], wq[2], wq[3]};
                if (m & 1) __builtin_amdgcn_sched_barrier(0);
            }
    }
};
struct EpiXres {
    static constexpr bool PERM = true, P16 = (P16_MASK & 8) != 0; static constexpr int BJ = P16 ? 8 : HALF;
    struct Pre {}; __device__ __forceinline__ void pre(const Unit&, int, Pre&) const {}
    const void* xsrc; void* xout; const float* gate; bool src_f32;
    __device__ __forceinline__ void operator()(const Acc& acc, const Unit& u, int wid, const Pre& PR) const {
        const int lane_ = lane_id(), wr = wid >> 2, wc = wid & 3, fr = lane_ & 15, fq = lane_ >> 4;
        const int row0 = u.pm * BM + wr * 64 + fr, col0 = u.pn * BM + (P16 ? wc * 64 + 16 * fq : wc * 32 + 8 * fq);
        const float* gp = gate + (size_t)((u.pm * BM) / S) * 6 * D + col0;
        f32x4 gv[2][2];
#pragma unroll
        for (int bj = 0; bj < 2; ++bj) { gv[bj][0] = *(const f32x4*)(gp + bj * BJ); gv[bj][1] = *(const f32x4*)(gp + bj * BJ + 4);
            if (G_FP8) { const float zs = KF(1.f / (HSCALE * WSCALE)); gv[bj][0] = gv[bj][0] * zs; gv[bj][1] = gv[bj][1] * zs; } }
#pragma unroll
        for (int ai = 0; ai < 2; ++ai)
#pragma unroll
            for (int m = 0; m < 4; ++m) {
                const size_t ro = (size_t)(row0 + ai * HALF + m * 16) * D + col0;
#pragma unroll
                for (int bj = 0; bj < 2; ++bj) {
                    if (X_BF16 && P16 && !src_f32) {
                        f32x4 x0, x1; unpack8(*(const u32x4*)((const unsigned short*)xsrc + ro + bj * BJ), x0, x1);
                        *(u32x4*)((unsigned short*)xout + ro + bj * BJ) = pack8(x0 + gv[bj][0] * acc[ai][bj][m][0], x1 + gv[bj][1] * acc[ai][bj][m][1]);
                    } else {
                    const f32x4 x0 = xload4(xsrc, ro + bj * BJ, src_f32), x1 = xload4(xsrc, ro + bj * BJ + 4, src_f32);
                    xstore4(xout, ro + bj * BJ, x0 + gv[bj][0] * acc[ai][bj][m][0]);
                    xstore4(xout, ro + bj * BJ + 4, x1 + gv[bj][1] * acc[ai][bj][m][1]);
                    }
                }
                if (m & 1) __builtin_amdgcn_sched_barrier(0);
            }
    }
};
struct EpiSwiglu {
    static constexpr bool PERM = true, P16 = false;
    struct Pre {}; __device__ __forceinline__ void pre(const Unit&, int, Pre&) const {}
    bf16* ACT; const float* bgu; const int* tile_exp;
    __device__ __forceinline__ void operator()(const Acc& acc, const Unit& u, int wid, const Pre& PR) const {
        const int lane_ = lane_id(), wr = wid >> 2, wc = wid & 3, fr = lane_ & 15, fq = lane_ >> 4;
        const int row0 = u.pm * BM + wr * 64 + fr, col0 = u.pn * HALF + wc * 32 + 8 * fq;
        const float* bp = bgu + (size_t)u.e * 2048 + col0;
        const f32x4 bg0 = *(const f32x4*)bp, bg1 = *(const f32x4*)(bp + 4), bl0 = *(const f32x4*)(bp + 1024), bl1 = *(const f32x4*)(bp + 1028);
#pragma unroll
        for (int ai = 0; ai < 2; ++ai)
#pragma unroll
            for (int m = 0; m < 4; ++m) {
                constexpr float zs = MOE_FP8 ? 1.f / (HSCALE * WSCALE) : 1.f, osc = MOE_FP8 ? ASCALE : 1.f;
                f32x4 o0, o1;
#pragma unroll
                for (int hh = 0; hh < 2; ++hh) {
                    const f32x4 ga = acc[ai][0][m][hh] * zs + (hh ? bg1 : bg0), la = acc[ai][1][m][hh] * zs + (hh ? bl1 : bl0);
                    f32x4 o;
#pragma unroll
                    for (int q = 0; q < 4; q += 2) {
                        f32x2 a = {fminf(ga[q], 7.f), fminf(ga[q + 1], 7.f)};
                        f32x2 b = {__builtin_amdgcn_fmed3f(la[q], -7.f, 7.f), __builtin_amdgcn_fmed3f(la[q + 1], -7.f, 7.f)};
                        const f32x2 ea = a * (-1.702f * 1.4426950408889634f);
                        f32x2 d = {__builtin_amdgcn_exp2f(ea.x), __builtin_amdgcn_exp2f(ea.y)}; d = d + 1.f;
                        const f32x2 r = {__builtin_amdgcn_rcpf(d.x), __builtin_amdgcn_rcpf(d.y)};
                        const f32x2 t = a * r, u = b * osc + osc, w = t * u;
                        o[q] = w.x; o[q + 1] = w.y;
                    }
                    if (hh) o1 = o; else o0 = o;
                }
                if (MOE_FP8) { u32x2 w; w.x = pk4_fp8<false>(o0[0], o0[1], o0[2], o0[3]); w.y = pk4_fp8<false>(o1[0], o1[1], o1[2], o1[3]);
                    *(u32x2*)((unsigned char*)ACT + (size_t)(row0 + ai * HALF + m * 16) * D + col0) = w; }
                else *(u32x4*)(ACT + (size_t)(row0 + ai * HALF + m * 16) * D + col0) = pack8(o0, o1);
            }
    }
};
struct EpiDown {
    static constexpr bool PERM = true, P16 = (P16_MASK & 16) != 0; static constexpr int BJ = P16 ? 8 : HALF;
    struct Pre {}; __device__ __forceinline__ void pre(const Unit&, int, Pre&) const {}
    bf16* Y; const float* bdn; const int* tile_exp; const float* row_gate;
    __device__ __forceinline__ void operator()(const Acc& acc, const Unit& u, int wid, const Pre& PR) const {
        const int lane_ = lane_id(), wr = wid >> 2, wc = wid & 3, fr = lane_ & 15, fq = lane_ >> 4;
        const int row0 = u.pm * BM + wr * 64 + fr, col0 = u.pn * BM + (P16 ? wc * 64 + 16 * fq : wc * 32 + 8 * fq);
        const float* bp = bdn + (size_t)u.e * D + col0;
        f32x4 bv[2][2];
#pragma unroll
        for (int bj = 0; bj < 2; ++bj) { bv[bj][0] = *(const f32x4*)(bp + bj * BJ); bv[bj][1] = *(const f32x4*)(bp + bj * BJ + 4); }
        float gts[2][4];
#pragma unroll
        for (int ai = 0; ai < 2; ++ai)
#pragma unroll
            for (int m = 0; m < 4; ++m) gts[ai][m] = row_gate[row0 + ai * HALF + m * 16] * (Y_FP8 ? YSCALE : 1.f);
#pragma unroll
        for (int ai = 0; ai < 2; ++ai)
#pragma unroll
            for (int m = 0; m < 4; ++m) {
                const int row = row0 + ai * HALF + m * 16; const float gt = gts[ai][m]; constexpr float ys = MOE_FP8 ? 1.f / (ASCALE * WSCALE) : 1.f;
                unsigned wq[4];
#pragma unroll
                for (int bj = 0; bj < 2; ++bj) {
                    const f32x4 o0 = (acc[ai][bj][m][0] * ys + bv[bj][0]) * gt, o1 = (acc[ai][bj][m][1] * ys + bv[bj][1]) * gt;
                    if (Y_FP8) { wq[2 * bj] = pk4_fp8(o0[0], o0[1], o0[2], o0[3]); wq[2 * bj + 1] = pk4_fp8(o1[0], o1[1], o1[2], o1[3]);
                        if (!P16) *(u32x2*)((unsigned char*)Y + (size_t)row * D + col0 + bj * BJ) = (u32x2){wq[2 * bj], wq[2 * bj + 1]}; }
                    else *(u32x4*)(Y + (size_t)row * D + col0 + bj * BJ) = pack8(o0, o1); }
                if (Y_FP8 && P16) *(u32x4*)((unsigned char*)Y + (size_t)row * D + col0) = (u32x4){wq[0], wq[1], wq[2], wq[3]};
            }
    }
};

template <class Epi, class Sched, bool ALIGN_EPI, bool FP8 = false>
__device__ __forceinline__ void gemm_phase(LAS unsigned char* lds, const int K, const Sched& S, const Epi& E, const int wid) {
    const int lane = lane_id(), tid = wid * 64 + lane, wr = wid >> 2, wc = wid & 3, fr = lane & 15, fq = lane >> 4;
    typedef int i32x4_ __attribute__((ext_vector_type(4))); typedef int i32x8_ __attribute__((ext_vector_type(8)));
    const int nt = K / BK;
    int rowA[2]; unsigned colA[2], voffB[2];
#pragma unroll
    for (int i = 0; i < 2; ++i) { int R, C; stage_rc(tid * 16 + i * 8192, R, C); const int p32 = perm32(R & 31); const int Rb = Epi::P16 ? ((R >> 5) * 64 + 16 * (p32 >> 3) + (p32 & 7)) : (Epi::PERM ? ((R & ~31) + p32) : R);
        rowA[i] = R; colA[i] = (unsigned)C * 2u; voffB[i] = (unsigned)(Rb * K + C) * 2u; }
    const size_t kstep = (size_t)(BK * 2);
    const size_t hstepB = (size_t)(Epi::P16 ? 8 : HALF) * K * 2;
    const size_t hstepA = (size_t)HALF * S.lda * 2;
    unsigned voffA[2];
#pragma unroll
    for (int i = 0; i < 2; ++i) voffA[i] = (unsigned)(rowA[i] * S.lda) * 2u + colA[i];
    const size_t step64A = (size_t)64 * S.lda * 2, step64B = (size_t)(Epi::P16 ? 128 : 64) * K * 2;
    const unsigned ldsw = (unsigned)wid * 1024u;
    const int aoff = lds_byte(wr * 64 + fr, fq * 8), boff = lds_byte(wc * 32 + fr, fq * 8);
#define PG8_SA(b, h) (((b) * 2 + (h)) * HTB)
#define PG8_SB(b, h) ((4 + (b) * 2 + (h)) * HTB)
#define PG8_STAGE(bufoff, gbase, voff) do { _Pragma("unroll") for (int _i = 0; _i < 2; ++_i) \
        __builtin_amdgcn_global_load_lds((const GAS unsigned*)((gbase) + (voff)[_i]), (LAS unsigned*)(lds + (bufoff) + ldsw + _i * 8192), 16, 0, 0); } while (0)
#define PG8_STAGE1(bufoff, gbase, voff0, step64) do { _Pragma("unroll") for (int _i = 0; _i < 2; ++_i) \
        __builtin_amdgcn_global_load_lds((const GAS unsigned*)((gbase) + (size_t)_i * (step64) + (voff0)), (LAS unsigned*)(lds + (bufoff) + ldsw + _i * 8192), 16, 0, 0); } while (0)
#define PG8_STAGE_A(bufoff, gbase, h, OARR) do { if constexpr (Sched::GATHER) { PG8_STAGE(bufoff, gbase, OARR[h]); } else { PG8_STAGE1(bufoff, (gbase) + (h) * hstepA, voffA[0], step64A); } } while (0)
#define PG8_STAGE_B(bufoff, gbase) PG8_STAGE1(bufoff, gbase, voffB[0], step64B)
#define PG8_LD8(p) __builtin_shufflevector(*(const LAS i32x4_*)(p), *(const LAS i32x4_*)((p) + 1024), 0, 1, 2, 3, 4, 5, 6, 7)
#define PG8_LDA(dst, b, h) do { _Pragma("unroll") for (int m = 0; m < 4; ++m) dst[m] = PG8_LD8(lds + PG8_SA(b, h) + aoff + m * 2048); } while (0)
#define PG8_LDB(dst, b, h) do { _Pragma("unroll") for (int n = 0; n < 2; ++n) dst[n] = PG8_LD8(lds + PG8_SB(b, h) + boff + n * 2048); } while (0)
#define PG8_MMA(ai, bj, At, Bt) do { __builtin_amdgcn_s_setprio(1); _Pragma("unroll") for (int m = 0; m < 4; ++m) _Pragma("unroll") for (int n = 0; n < 2; ++n) { \
        if constexpr (FP8) asm volatile("v_mfma_f32_16x16x128_f8f6f4 %0, %1, %2, %0" : "+v"(acc[ai][bj][m][n]) : "v"(Bt[n]), "v"(At[m]));       \
        else { acc[ai][bj][m][n] = __builtin_amdgcn_mfma_f32_16x16x32_bf16(__builtin_bit_cast(bf16x8, __builtin_shufflevector(Bt[n], Bt[n], 0, 1, 2, 3)), __builtin_bit_cast(bf16x8, __builtin_shufflevector(At[m], At[m], 0, 1, 2, 3)), acc[ai][bj][m][n], 0, 0, 0); \
               acc[ai][bj][m][n] = __builtin_amdgcn_mfma_f32_16x16x32_bf16(__builtin_bit_cast(bf16x8, __builtin_shufflevector(Bt[n], Bt[n], 4, 5, 6, 7)), __builtin_bit_cast(bf16x8, __builtin_shufflevector(At[m], At[m], 4, 5, 6, 7)), acc[ai][bj][m][n], 0, 0, 0); } } \
        __builtin_amdgcn_s_setprio(0); } while (0)
#define PG8_WAIT_V(n) asm volatile("s_waitcnt vmcnt(" #n ")" ::: "memory")
#define PG8_WAIT_L(n) asm volatile("s_waitcnt lgkmcnt(" #n ")" ::: "memory")
#define PG8_BAR __builtin_amdgcn_s_barrier()
#define PG8_SCHED __builtin_amdgcn_sched_barrier(0)
#define PG8_PIN do { } while (0)
    Unit cur, nxt; int ui = 0;
    if (!S.next(0, cur)) return;
    typename Epi::Pre epre;
    Acc acc;
#pragma unroll
    for (int a = 0; a < 2; ++a)
#pragma unroll
        for (int b = 0; b < 2; ++b)
#pragma unroll
            for (int m = 0; m < 4; ++m)
#pragma unroll
                for (int n = 0; n < 2; ++n) acc[a][b][m][n] = (f32x4){0.f, 0.f, 0.f, 0.f};
    i32x8_ At[4], B0[2], B1[2];
    const int sc1 = 0x7F7F7F7F;
    unsigned oc[2][2], on[2][2];
    if constexpr (Sched::GATHER) S.a_offs(cur, rowA, colA, oc); else { oc[0][0] = oc[0][1] = oc[1][0] = oc[1][1] = 0u; }
#pragma unroll
    for (int h = 0; h < 2; ++h)
#pragma unroll
        for (int i = 0; i < 2; ++i) on[h][i] = oc[h][i];
    typedef const GAS char* gptr;
    gptr cA = (gptr)S.a_ptr(cur); gptr cB = (gptr)S.b_ptr(cur);
    PG8_STAGE_B(PG8_SB(0, 0), cB); PG8_STAGE_B(PG8_SB(0, 1), cB + hstepB); PG8_STAGE_A(PG8_SA(0, 0), cA, 0, oc); PG8_STAGE_A(PG8_SA(0, 1), cA, 1, oc);
    if (wr == 1) PG8_BAR;
    PG8_WAIT_V(2); PG8_BAR;
    PG8_STAGE_B(PG8_SB(1, 0), cB + kstep); PG8_STAGE_A(PG8_SA(1, 0), cA + kstep, 0, oc); PG8_STAGE_B(PG8_SB(1, 1), cB + hstepB + kstep);
    PG8_WAIT_V(6); PG8_BAR;
    for (;;) {
        const bool has_next = S.next(ui + 1, nxt);
        gptr nA = has_next ? (gptr)S.a_ptr(nxt) : cA; gptr nB = has_next ? (gptr)S.b_ptr(nxt) : cB;
        if (Sched::GATHER) { if (has_next) S.a_offs(nxt, rowA, colA, on); }
#pragma unroll 1
        for (int t = 0; t < nt; t += 2) {
            const bool last = (t == nt - 2);
            if (last) E.pre(cur, wid, epre);
            gptr a1 = cA + (size_t)(t + 1) * kstep;
            gptr a2 = last ? nA : cA + (size_t)(t + 2) * kstep; gptr b2 = last ? nB : cB + (size_t)(t + 2) * kstep;
            gptr a3 = a2 + kstep; gptr b3 = b2 + kstep;
            unsigned o2[2][2];
#pragma unroll
            for (int h = 0; h < 2; ++h)
#pragma unroll
                for (int i = 0; i < 2; ++i) o2[h][i] = (Sched::GATHER && last) ? on[h][i] : oc[h][i];
            PG8_LDB(B0, 0, 0); PG8_LDB(B1, 0, 1); PG8_SCHED; PG8_LDA(At, 0, 0); PG8_STAGE_A(PG8_SA(1, 1), a1, 1, oc);
            PG8_WAIT_V(8); PG8_WAIT_L(0); PG8_BAR; PG8_PIN; PG8_MMA(0, 0, At, B0); PG8_MMA(0, 1, At, B1); PG8_PIN; PG8_BAR; PG8_SCHED;
            PG8_LDA(At, 0, 1); PG8_STAGE_B(PG8_SB(0, 0), b2); PG8_STAGE_B(PG8_SB(0, 1), b2 + hstepB); PG8_STAGE_A(PG8_SA(0, 0), a2, 0, o2);
            PG8_WAIT_V(8); PG8_WAIT_L(0); PG8_BAR; PG8_PIN; PG8_MMA(1, 0, At, B0); PG8_MMA(1, 1, At, B1); PG8_PIN; PG8_BAR; PG8_SCHED;
            PG8_LDB(B0, 1, 0); PG8_LDB(B1, 1, 1); PG8_SCHED; PG8_LDA(At, 1, 0); PG8_STAGE_A(PG8_SA(0, 1), a2, 1, o2);
            PG8_WAIT_V(8); PG8_WAIT_L(0); PG8_BAR; PG8_PIN; PG8_MMA(0, 0, At, B0); PG8_MMA(0, 1, At, B1); PG8_PIN; PG8_BAR; PG8_SCHED;
            PG8_LDA(At, 1, 1); PG8_STAGE_B(PG8_SB(1, 0), b3); PG8_STAGE_B(PG8_SB(1, 1), b3 + hstepB); PG8_STAGE_A(PG8_SA(1, 0), a3, 0, o2);
            PG8_WAIT_V(8); PG8_WAIT_L(0); PG8_BAR; PG8_PIN; PG8_MMA(1, 0, At, B0); PG8_MMA(1, 1, At, B1); PG8_PIN; PG8_BAR; PG8_SCHED;
        }
        if constexpr (ALIGN_EPI) { if (wr == 0) PG8_BAR; }
        if constexpr (FP8) asm volatile("s_nop 15\n\ts_nop 15" ::: "memory");
        E(acc, cur, wid, epre);
        if (!has_next) break;
#pragma unroll
        for (int a = 0; a < 2; ++a)
#pragma unroll
            for (int b = 0; b < 2; ++b)
#pragma unroll
                for (int m = 0; m < 4; ++m)
#pragma unroll
                    for (int n = 0; n < 2; ++n) acc[a][b][m][n] = (f32x4){0.f, 0.f, 0.f, 0.f};
        cur = nxt; cA = nA; cB = nB; ++ui;
#pragma unroll
        for (int h = 0; h < 2; ++h)
#pragma unroll
            for (int i = 0; i < 2; ++i) oc[h][i] = on[h][i];
        if constexpr (ALIGN_EPI) { if (wr == 1) PG8_BAR; }
    }
    PG8_WAIT_V(0);
    if constexpr (!ALIGN_EPI) { if (wr == 0) PG8_BAR; }
    PG8_BAR;
#undef PG8_SA
#undef PG8_SB
#undef PG8_STAGE
#undef PG8_STAGE_A
#undef PG8_STAGE_B
#undef PG8_STAGE1
#undef PG8_LD8
#undef PG8_LDA
#undef PG8_LDB
#undef PG8_MMA
#undef PG8_WAIT_V
#undef PG8_WAIT_L
#undef PG8_BAR
#undef PG8_SCHED
#undef PG8_PIN
}

constexpr size_t MiB = 1u << 20;
constexpr size_t al(size_t x) { return (x + 4095) & ~(size_t)4095; }
constexpr size_t WS_CTL = 0, CTL_WORDS_BYTES = 2 * MiB;
constexpr size_t WS_MOD = WS_CTL + CTL_WORDS_BYTES;
constexpr size_t MOD_BYTES = (size_t)DEPTH * NB * 6 * D * 4;
constexpr size_t ZERO_BYTES = al(CTL_WORDS_BYTES + MOD_BYTES);
constexpr size_t WS_ROPE = ZERO_BYTES;
constexpr size_t WS_RWT = al(WS_ROPE + (size_t)S * 16 * 4);
constexpr size_t WS_WIN = al(WS_RWT + (size_t)DEPTH * NE * D * 4);
constexpr size_t WS_WA = al(WS_WIN + (size_t)DEPTH * IN_COLS * D * 2);
constexpr size_t WS_WP = al(WS_WA + (size_t)DEPTH * D * 256 * 2);
constexpr size_t WS_WOUT = al(WS_WP + (size_t)DEPTH * D * 512 * 2);
constexpr size_t WS_WGU = al(WS_WOUT + (size_t)DEPTH * D * D * 2);
constexpr size_t WS_WDN = al(WS_WGU + (size_t)DEPTH * NE * 2048 * D * EB);
constexpr size_t WS_H8 = al(WS_WDN + (size_t)DEPTH * NE * D * D * EB);
constexpr size_t WS_X = al(WS_H8 + (size_t)T * D);
constexpr size_t WS_H = al(WS_X + (size_t)T * D * 4);
constexpr size_t WS_Q = al(WS_H + (size_t)T * D * 2);
constexpr size_t WS_K = al(WS_Q + (size_t)T * 768 * 2);
constexpr size_t WS_V = al(WS_K + (size_t)T * 768 * 2);
constexpr size_t WS_U = al(WS_V + (size_t)T * 768 * 2);
constexpr size_t WS_GA = al(WS_U + (size_t)T * 512 * 2);
constexpr size_t WS_GP = al(WS_GA + (size_t)T * D * 2);
constexpr size_t WS_OG = al(WS_GP + (size_t)T * D * 2);
constexpr size_t WS_LSE = al(WS_OG + (size_t)T * 768 * 2);
constexpr size_t WS_AD = al(WS_LSE + (size_t)T * 12 * 4);
constexpr size_t WS_MA = al(WS_AD + (size_t)T * 768 * 2);
constexpr size_t WS_MG = al(WS_MA + (size_t)T * D * 2);
constexpr size_t WS_TOPE = al(WS_MG + (size_t)T * D * 2);
constexpr size_t WS_TOPG = al(WS_TOPE + (size_t)NASSIGN * 4);
constexpr size_t WS_LRANK = al(WS_TOPG + (size_t)NASSIGN * 4);
constexpr size_t WS_HIST = al(WS_LRANK + (size_t)NASSIGN * 4);
constexpr size_t WS_ROWTOK = al(WS_HIST + (size_t)GRID * NE * 4);
constexpr size_t WS_ROWGATE = al(WS_ROWTOK + (size_t)NROWS_MAX * 4);
constexpr size_t WS_TOKROW = al(WS_ROWGATE + (size_t)NROWS_MAX * 4);
constexpr size_t WS_TILEEXP = al(WS_TOKROW + (size_t)NASSIGN * 4);
constexpr size_t WS_ACT = al(WS_TILEEXP + (size_t)(NROWS_MAX / RPAD + 16) * 4);
constexpr size_t WS_Y = al(WS_ACT + (size_t)NROWS_MAX * D * 2);
constexpr size_t WS_END = al(WS_Y + (size_t)NROWS_MAX * D * 2);
constexpr int NRT_SLOT = NROWS_MAX / RPAD + 8;

constexpr int CW_BAR = 4096, BAR_REGION_WORDS = 4096, MAX_LAUNCHES = 100;
static_assert((CW_BAR + MAX_LAUNCHES * BAR_REGION_WORDS) * 4 <= (int)CTL_WORDS_BYTES, "ctl");

constexpr int RING_BYTES = 131072, MISC_OFF = RING_BYTES, LDS_BYTES = 147456;

#define XB_TMO      128
#define XB_XCNT(j)  (256  + 64 * (j))
#define XB_XSUB(j)  (1280 + 64 * (j))
#define XB_XGEN(j)  (2304 + 64 * (j))
#define XB_TOP      3328
#define XB_TOPGEN   3392
#define XCD_BAR_WORDS 3456
#define XB_SPIN_CAP (1u << 18)
__device__ __forceinline__ unsigned xb_ld(unsigned* p)              { return __hip_atomic_load(p, __ATOMIC_RELAXED, __HIP_MEMORY_SCOPE_AGENT); }
__device__ __forceinline__ unsigned xb_add(unsigned* p, unsigned v) { return __hip_atomic_fetch_add(p, v, __ATOMIC_RELAXED, __HIP_MEMORY_SCOPE_AGENT); }
__device__ __forceinline__ unsigned xb_xcc_id() { return (unsigned)__builtin_amdgcn_s_getreg((3 << 11) | 20) & 0xFu; }
#define XB_SPIN(cond, bar) do { unsigned _sp = 0; while (cond) { __builtin_amdgcn_s_sleep(1); \
    if ((++_sp & 255u) == 0u) { if (xb_ld(&(bar)[XB_TMO])) break; if (_sp > XB_SPIN_CAP) { atomicAdd(&(bar)[XB_TMO], 1u); break; } } } } while (0)
struct XcdBarrier { unsigned* bar; unsigned x; volatile LAS unsigned* st; };
__device__ __forceinline__ XcdBarrier xcd_barrier_post(unsigned* bar, volatile LAS unsigned* st, const bool leader  ) {
    XcdBarrier b; b.bar = bar; b.x = xb_xcc_id(); b.st = st;
    if (leader) (void)xb_add(&bar[XB_XCNT(b.x)], 1u);
    return b;
}
__device__ __forceinline__ void xcd_barrier_complete(unsigned* bar, unsigned x, unsigned& nloc, unsigned& nx) {
    const unsigned G = gridDim.x * gridDim.y * gridDim.z;
    unsigned sum, cnt, mine, sp = 0u;
    for (;;) {
        sum = 0u; cnt = 0u; mine = 0u;
#pragma unroll
        for (unsigned j = 0; j < 16; ++j) { const unsigned c = xb_ld(&bar[XB_XCNT(j)]); sum += c; cnt += (c > 0u) ? 1u : 0u; mine = (j == x) ? c : mine; }
        if (sum == G) break;
        __builtin_amdgcn_s_sleep(1);
        if ((++sp & 255u) == 0u) { if (xb_ld(&bar[XB_TMO])) break; if (sp > XB_SPIN_CAP) { atomicAdd(&bar[XB_TMO], 1u); break; } }
    }
    nloc = mine > 0u ? mine : 1u; nx = cnt > 0u ? cnt : 1u;
}
__device__ __forceinline__ void xcd_barrier(const XcdBarrier& b, const bool leader  ) {
    asm volatile("s_waitcnt vmcnt(0)" ::: "memory");
    __syncthreads();
    if (leader) {
        unsigned* bar = b.bar;
        __builtin_amdgcn_s_waitcnt(0);
        unsigned nloc = b.st[0], nx = b.st[1];
        if (nloc == 0u) { xcd_barrier_complete(bar, b.x, nloc, nx); b.st[0] = nloc; b.st[1] = nx; }
        const unsigned old = xb_add(&bar[XB_XSUB(b.x)], 1u);
        const unsigned gen = old / nloc;
        if (old + 1u == (gen + 1u) * nloc) {
            __builtin_amdgcn_fence(__ATOMIC_RELEASE, "agent");
            asm volatile("s_waitcnt vmcnt(0)" ::: "memory");
            const unsigned og = xb_add(&bar[XB_TOP], 1u);
            const unsigned tg = og / nx;
            if (og + 1u == (tg + 1u) * nx) xb_add(&bar[XB_TOPGEN], 1u);
            else XB_SPIN(xb_ld(&bar[XB_TOPGEN]) == tg, bar);
            __builtin_amdgcn_fence(__ATOMIC_ACQUIRE, "agent");
            xb_add(&bar[XB_XGEN(b.x)], 1u);
            asm volatile("s_waitcnt vmcnt(0)" ::: "memory");
        } else {
            XB_SPIN(xb_ld(&bar[XB_XGEN(b.x)]) == gen, bar);
            __builtin_amdgcn_fence(__ATOMIC_ACQUIRE, "agent");
            asm volatile("s_waitcnt vmcnt(0)" ::: "memory");
        }
    }
    __syncthreads();
}

struct Args {
    const float* in[19]; float* out; unsigned char* ws;
    int ph_lo, ph_hi, li, flags;
};
struct Frame {
    LAS unsigned char* lds; int wave, G, blk;
    unsigned char* ws;
    const float *x_in, *c, *ada_w, *ada_b, *norm1_g, *w_in, *pool_w, *pool_scale, *w_ab, *w_pb, *w_out, *norm2_g, *router_w, *router_b, *w_gu, *b_gu, *w_down, *b_down, *final_g;
    float* out;
};
#define WSP(type, off) ((type*)(F.ws + (off)))
typedef __attribute__((address_space(4))) const Args CArgs;
__device__ __forceinline__ CArgs* kargs() { CArgs* p = (CArgs*)__builtin_amdgcn_kernarg_segment_ptr(); asm volatile("" : "+s"(p)); return p; }
__device__ __forceinline__ Frame make_frame(CArgs* a, LAS unsigned char* lds, int wave) {
    Frame F; F.lds = lds; F.wave = wave; F.G = gridDim.x; F.blk = blockIdx.x; F.ws = a->ws;
    F.x_in = a->in[0]; F.c = a->in[1]; F.ada_w = a->in[2]; F.ada_b = a->in[3]; F.norm1_g = a->in[4]; F.w_in = a->in[5]; F.pool_w = a->in[6]; F.pool_scale = a->in[7];
    F.w_ab = a->in[8]; F.w_pb = a->in[9]; F.w_out = a->in[10]; F.norm2_g = a->in[11]; F.router_w = a->in[12]; F.router_b = a->in[13]; F.w_gu = a->in[14]; F.b_gu = a->in[15];
    F.w_down = a->in[16]; F.b_down = a->in[17]; F.final_g = a->in[18]; F.out = a->out;
    return F;
}

template <class DestFn>
__device__ __forceinline__ void transpose_item(const float* W, int K, int N, bf16* WT, const DestFn& dest, LAS float* scr, int item, int lane) {
    const int nblk = N / 32, kb = item / nblk, nb = item % nblk, k0 = 64 * kb, n0 = 32 * nb;
    float wv[32];
#pragma unroll
    for (int i = 0; i < 32; ++i) wv[i] = __builtin_nontemporal_load(W + (size_t)(k0 + 2 * i + (lane >> 5)) * N + n0 + (lane & 31));
#pragma unroll
    for (int i = 0; i < 32; ++i) scr[(2 * i + (lane >> 5)) * 33 + (lane & 31)] = wv[i];
    asm volatile("s_waitcnt lgkmcnt(0)" ::: "memory");
    const int c = lane & 7;
#pragma unroll
    for (int j = 0; j < 4; ++j) { const int n = (lane >> 3) + 8 * j; const LAS float* s = scr + (8 * c) * 33 + n;
        u32x4 o; o.x = pk2(s[0 * 33], s[1 * 33]); o.y = pk2(s[2 * 33], s[3 * 33]); o.z = pk2(s[4 * 33], s[5 * 33]); o.w = pk2(s[6 * 33], s[7 * 33]);
        *(u32x4*)(WT + (size_t)dest(n0 + n) * K + k0 + 8 * c) = o; }
    asm volatile("s_waitcnt lgkmcnt(0)" ::: "memory");
}
__device__ __forceinline__ void t8_load(const float* W, int N, int item, int lane, float (&wv)[32]) {
    const int nblk = N / 32, kb = item / nblk, nb = item % nblk, k0 = 64 * kb, n0 = 32 * nb;
#pragma unroll
    for (int i = 0; i < 32; ++i) wv[i] = __builtin_nontemporal_load(W + (size_t)(k0 + 2 * i + (lane >> 5)) * N + n0 + (lane & 31));
}
template <class DestFn>
__device__ __forceinline__ void t8_store(const float (&wv)[32], int K, int N, unsigned char* WT, const DestFn& dest, LAS float* scr, int item, int lane, float scale) {
    const int nblk = N / 32, kb = item / nblk, nb = item % nblk, k0 = 64 * kb, n0 = 32 * nb;
#pragma unroll
    for (int i = 0; i < 32; ++i) scr[(2 * i + (lane >> 5)) * 33 + (lane & 31)] = wv[i];
    asm volatile("s_waitcnt lgkmcnt(0)" ::: "memory");
    const int c = lane & 7;
#pragma unroll
    for (int j = 0; j < 4; ++j) { const int n = (lane >> 3) + 8 * j; const LAS float* sp = scr + (8 * c) * 33 + n;
        u32x2 o; o.x = pk4_fp8(sp[0 * 33] * scale, sp[1 * 33] * scale, sp[2 * 33] * scale, sp[3 * 33] * scale); o.y = pk4_fp8(sp[4 * 33] * scale, sp[5 * 33] * scale, sp[6 * 33] * scale, sp[7 * 33] * scale);
        *(u32x2*)(WT + (size_t)dest(n0 + n) * K + k0 + 8 * c) = o; }
    asm volatile("s_waitcnt lgkmcnt(0)" ::: "memory");
}
constexpr int T8B_PITCH = 260;
__device__ __forceinline__ void t8b_load(const float* W, int N, int k0, int n0, int wave, int lane, f32x4 (&v)[4][4]) {
#pragma unroll
    for (int j = 0; j < 4; ++j)
#pragma unroll
        for (int r = 0; r < 4; ++r) v[j][r] = __builtin_nontemporal_load((const f32x4*)(W + (size_t)(k0 + 16 * wave + 4 * j + r) * N + n0 + 4 * lane));
}
template <class DestFn>
__device__ __forceinline__ void t8b_store(const f32x4 (&v)[4][4], int K, unsigned char* WT, const DestFn& dest, int k0, int n0, LAS unsigned* L, int wave, int lane, float scale) {
#pragma unroll
    for (int j = 0; j < 4; ++j) {
        u32x4 w;
#pragma unroll
        for (int c = 0; c < 4; ++c) w[c] = pk4_fp8(v[j][0][c] * scale, v[j][1][c] * scale, v[j][2][c] * scale, v[j][3][c] * scale);
        *(LAS u32x4*)(L + (wave * 4 + j) * T8B_PITCH + 4 * lane) = w;
    }
    __syncthreads();
    const int tid = wave * 64 + lane;
#pragma unroll
    for (int q4 = 0; q4 < 4; ++q4) {
        const int p = tid + NTHREADS * q4, n = p >> 3, g = p & 7;
        u32x4 o;
#pragma unroll
        for (int q = 0; q < 4; ++q) o[q] = L[(4 * g + q) * T8B_PITCH + n];
        *(u32x4*)(WT + (size_t)dest(n0 + n) * K + k0 + 16 * g) = o;
    }
    __syncthreads();
}
struct DestId { __device__ __forceinline__ int operator()(int n) const { return n; } };
struct DestWin {
    __device__ __forceinline__ int operator()(int n) const { if (n >= 1536 || (n & 63) >= 16) return n; const int d = n & 15; return (n & ~15) | (d & 3) | (((d >> 3) & 1) << 2) | (((d >> 2) & 1) << 3); } };
struct DestGu {
    __device__ __forceinline__ int operator()(int n) const { const int j = n & 1023; return (j >> 7) * 256 + (n >> 10) * 128 + (j & 127); } };

__device__ __forceinline__ void prologue_small(const Frame& F, const int MASK = 31) {
    const int gw = F.blk * NWAVES + F.wave, NGW = F.G * NWAVES, lane = lane_id(), tid_p = F.wave * 64 + lane;
    if (MASK & 1) {
        LAS float* cact = (LAS float*)F.lds;
        LAS f32x4* part = (LAS f32x4*)(F.lds + 65536);
        float* mod = WSP(float, WS_MOD);
        constexpr int NITEM = DEPTH * 24;
        if (F.blk < NITEM) {
            for (int i = tid_p; i < NB * D; i += NTHREADS) { const int bb = i / D, k = i % D; const float v = F.c[i]; cact[k * NB + bb] = v / (1.f + __expf(-v)); }
            __syncthreads();
        }
        for (int it = F.blk; it < NITEM; it += F.G) {
            const int kc = F.wave, jb = it % 24, l = it / 24, j = jb * 256 + 4 * lane;
            f32x4 acc[NB];
#pragma unroll
            for (int bb = 0; bb < NB; ++bb) acc[bb] = (f32x4){0.f, 0.f, 0.f, 0.f};
            const float* wp = F.ada_w + ((size_t)l * D + kc * 128) * (6 * D) + j;
#pragma unroll 1
            for (int k0 = 0; k0 < 128; k0 += 16) {
                f32x4 wv[16];
#pragma unroll
                for (int u = 0; u < 16; ++u) wv[u] = __builtin_nontemporal_load((const f32x4*)(wp + (size_t)(k0 + u) * (6 * D)));
#pragma unroll
                for (int u = 0; u < 16; ++u) {
                    const LAS f32x4* cp = (const LAS f32x4*)(cact + (kc * 128 + k0 + u) * NB);
#pragma unroll
                    for (int q = 0; q < 4; ++q) { const f32x4 cv = cp[q]; acc[4 * q] += wv[u] * cv[0]; acc[4 * q + 1] += wv[u] * cv[1]; acc[4 * q + 2] += wv[u] * cv[2]; acc[4 * q + 3] += wv[u] * cv[3]; }
                }
            }
#pragma unroll
            for (int rnd = 0; rnd < 2; ++rnd) {
#pragma unroll
                for (int bb = 0; bb < 8; ++bb) part[(kc * 8 + bb) * 64 + lane] = acc[rnd * 8 + bb];
                __syncthreads();
                const int bo = rnd * 8 + F.wave;
                f32x4 sum = *(const f32x4*)(F.ada_b + l * 6 * D + j);
#pragma unroll
                for (int w = 0; w < NWAVES; ++w) sum += part[(w * 8 + F.wave) * 64 + lane];
                *(f32x4*)(mod + ((size_t)l * NB + bo) * (6 * D) + j) = sum;
                __syncthreads();
            }
        }
        __syncthreads();
    }
    if (MASK & 2) {
        float* rope = WSP(float, WS_ROPE);
        for (int i = gw * 64 + lane; i < S * 8; i += NGW * 64) {
            const int s = i >> 3, j = i & 7;
            const float invs[8] = {1.0f, 0.1939227432012558f, 0.03760603070259094f, 0.007292664609849453f, 0.0014142135623842478f, 0.00027424818836152554f, 5.318296098266728e-05f, 1.0313386155758053e-05f};
            float inv = invs[0];
#pragma unroll
            for (int q = 1; q < 8; ++q) inv = (j == q) ? invs[q] : inv;
            const float ang = (float)s * inv;
            rope[s * 16 + j] = cosf(ang); rope[s * 16 + 8 + j] = sinf(ang);
        }
    }
    if (MASK & 4) {
        float* rwt = WSP(float, WS_RWT);
        for (int i = gw * 64 + lane; i < DEPTH * NE * D; i += NGW * 64) { const int k = i & (D - 1), e = (i >> 10) & (NE - 1), l = i >> 15; rwt[i] = F.router_w[((size_t)l * D + k) * NE + e]; }
    }
    if (MASK & 8) {
        bf16* WP = WSP(bf16, WS_WP);
        LAS float* pwl = (LAS float*)F.lds;
        constexpr int NITEM = DEPTH * 4 * 16;
        for (int it = F.blk; it < NITEM; it += F.G) {
            const int nbk = it & 15, g = (it >> 4) & 3, l = it >> 6, n = nbk * 64 + lane;
            const float* pw = F.pool_w + ((size_t)l * 4 + g) * 128 * 128;
            const float* ps = F.pool_scale + l * 512 + g * 128;
            __syncthreads();
            for (int i = tid_p; i < 128 * 128; i += NTHREADS) { const int c = i >> 7, d = i & 127; pwl[d * 128 + c] = pw[i] * ps[d]; }
            __syncthreads();
            float acc[16];
#pragma unroll
            for (int q = 0; q < 16; ++q) acc[q] = 0.f;
            const float* wb = F.w_pb + ((size_t)l * 512 + g * 128) * D + n;
#pragma unroll 1
            for (int d0 = 0; d0 < 128; d0 += 32) {
                float wv[32];
#pragma unroll
                for (int u = 0; u < 32; ++u) wv[u] = wb[(size_t)(d0 + u) * D];
#pragma unroll
                for (int u = 0; u < 32; ++u) {
                    const LAS f32x4* cp = (const LAS f32x4*)(pwl + (d0 + u) * 128 + 16 * F.wave);
#pragma unroll
                    for (int q = 0; q < 4; ++q) { const f32x4 cv = cp[q]; acc[4 * q] += cv[0] * wv[u]; acc[4 * q + 1] += cv[1] * wv[u]; acc[4 * q + 2] += cv[2] * wv[u]; acc[4 * q + 3] += cv[3] * wv[u]; }
                }
            }
            u32x4 o0, o1;
            o0.x = pk2(acc[0], acc[1]); o0.y = pk2(acc[2], acc[3]); o0.z = pk2(acc[4], acc[5]); o0.w = pk2(acc[6], acc[7]);
            o1.x = pk2(acc[8], acc[9]); o1.y = pk2(acc[10], acc[11]); o1.z = pk2(acc[12], acc[13]); o1.w = pk2(acc[14], acc[15]);
            bf16* op = WP + ((size_t)l * D + n) * 512 + g * 128 + 16 * F.wave;
            *(u32x4*)op = o0; *(u32x4*)(op + 8) = o1;
        }
        __syncthreads();
    }
    if (MASK & 16) {
        LAS float* scr = (LAS float*)(F.lds + F.wave * 16384);
        { constexpr int PER = (D / 64) * (IN_COLS / 32); const DestWin dw;
          for (int it = gw; it < DEPTH * PER; it += NGW) { const int l = it / PER;
              if (B_FP8) { float wv[32]; t8_load(F.w_in + (size_t)l * D * IN_COLS, IN_COLS, it % PER, lane, wv); t8_store(wv, D, IN_COLS, WSP(unsigned char, WS_WIN) + (size_t)l * IN_COLS * D, dw, scr, it % PER, lane, WSCALE); }
              else transpose_item(F.w_in + (size_t)l * D * IN_COLS, D, IN_COLS, WSP(bf16, WS_WIN) + (size_t)l * IN_COLS * D, dw, scr, it % PER, lane); } }
        { constexpr int PER = (256 / 64) * (D / 32); const DestId di;
          for (int it = gw; it < DEPTH * PER; it += NGW) { const int l = it / PER; transpose_item(F.w_ab + (size_t)l * 256 * D, 256, D, WSP(bf16, WS_WA) + (size_t)l * D * 256, di, scr, it % PER, lane); } }
        { constexpr int PER = (D / 64) * (D / 32); const DestId di;
          for (int it = gw; it < DEPTH * PER; it += NGW) { const int l = it / PER;
              if (G_FP8) { float wv[32]; t8_load(F.w_out + (size_t)l * D * D, D, it % PER, lane, wv); t8_store(wv, D, D, WSP(unsigned char, WS_WOUT) + (size_t)l * D * D, di, scr, it % PER, lane, WSCALE); }
              else transpose_item(F.w_out + (size_t)l * D * D, D, D, WSP(bf16, WS_WOUT) + (size_t)l * D * D, di, scr, it % PER, lane); } }
    }
}
constexpr int CT_PER_GU = (D / 128) * (2048 / 256), CT_PER_DN = (D / 128) * (D / 256), CT_N_GU = DEPTH * NE * CT_PER_GU, CT_NIT = CT_N_GU + DEPTH * NE * CT_PER_DN;
__device__ __forceinline__ void convert_tile(const Frame& F, int it, int lane) {
    const DestGu dg; const DestId di; LAS unsigned* L = (LAS unsigned*)F.lds; f32x4 v[4][4];
    if (it < CT_N_GU) { const int le = it / CT_PER_GU, r = it % CT_PER_GU; t8b_load(F.w_gu + (size_t)le * D * 2048, 2048, 128 * (r >> 3), 256 * (r & 7), F.wave, lane, v);
        t8b_store(v, D, WSP(unsigned char, WS_WGU) + (size_t)le * 2048 * D, dg, 128 * (r >> 3), 256 * (r & 7), L, F.wave, lane, WSCALE); }
    else { const int q = it - CT_N_GU, le = q / CT_PER_DN, r = q % CT_PER_DN; t8b_load(F.w_down + (size_t)le * D * D, D, 128 * (r >> 2), 256 * (r & 3), F.wave, lane, v);
        t8b_store(v, D, WSP(unsigned char, WS_WDN) + (size_t)le * D * D, di, 128 * (r >> 2), 256 * (r & 3), L, F.wave, lane, WSCALE); }
}
constexpr int CT_PER_LAYER = NE * (CT_PER_GU + CT_PER_DN);
constexpr int CW_CQ = 3072;
__device__ __forceinline__ int ct_global(int t, int j) { return j < NE * CT_PER_GU ? t * NE * CT_PER_GU + j : CT_N_GU + t * NE * CT_PER_DN + (j - NE * CT_PER_GU); }
__device__ __forceinline__ int ct_dequeue(const Frame& F, int t, int lane) {
    LAS int* slot = (LAS int*)(F.lds + MISC_OFF + 512);
    if (F.wave == 0 && lane == 0) *slot = (int)__hip_atomic_fetch_add((unsigned*)(F.ws + WS_CTL) + CW_CQ + 64 * t, 1u, __ATOMIC_RELAXED, __HIP_MEMORY_SCOPE_AGENT);
    __syncthreads();
    const int j = *slot;
    __syncthreads();
    return j;
}
__device__ __forceinline__ void tail_convert(const Frame& F, int t, int n) {
    const int lane = lane_id();
    for (int q = 0; q < n && t < DEPTH; ) {
        const int j = ct_dequeue(F, t, lane);
        if (j >= CT_PER_LAYER) { ++t; continue; }
        convert_tile(F, ct_global(t, j), lane); ++q;
    }
}
__device__ __forceinline__ void drain_convert(const Frame& F, int t) {
    const int lane = lane_id();
    for (;;) { const int j = ct_dequeue(F, t, lane); if (j >= CT_PER_LAYER) break; convert_tile(F, ct_global(t, j), lane); }
}
__device__ __forceinline__ void drain_static(const Frame& F, int t) {
    const int lane = lane_id();
    int h0 = (int)__hip_atomic_load((unsigned*)(F.ws + WS_CTL) + CW_CQ + 64 * t, __ATOMIC_RELAXED, __HIP_MEMORY_SCOPE_AGENT); h0 = __builtin_amdgcn_readfirstlane(h0);
    const DestGu dg; const DestId di; LAS unsigned* L = (LAS unsigned*)F.lds;
    f32x4 cur[4][4], nxt[4][4];
    auto ld = [&](int j, f32x4 (&v)[4][4]) { const int it = ct_global(t, j);
        if (it < CT_N_GU) { const int le = it / CT_PER_GU, r = it % CT_PER_GU; t8b_load(F.w_gu + (size_t)le * D * 2048, 2048, 128 * (r >> 3), 256 * (r & 7), F.wave, lane, v); }
        else { const int q = it - CT_N_GU, le = q / CT_PER_DN, r = q % CT_PER_DN; t8b_load(F.w_down + (size_t)le * D * D, D, 128 * (r >> 2), 256 * (r & 3), F.wave, lane, v); } };
    auto st = [&](int j, const f32x4 (&v)[4][4]) { const int it = ct_global(t, j);
        if (it < CT_N_GU) { const int le = it / CT_PER_GU, r = it % CT_PER_GU; t8b_store(v, D, WSP(unsigned char, WS_WGU) + (size_t)le * 2048 * D, dg, 128 * (r >> 3), 256 * (r & 7), L, F.wave, lane, WSCALE); }
        else { const int q = it - CT_N_GU, le = q / CT_PER_DN, r = q % CT_PER_DN; t8b_store(v, D, WSP(unsigned char, WS_WDN) + (size_t)le * D * D, di, 128 * (r >> 2), 256 * (r & 3), L, F.wave, lane, WSCALE); } };
    __syncthreads();
    int j = h0 + F.blk;
    if (j < CT_PER_LAYER) ld(j, cur);
#pragma unroll 1
    for (; j < CT_PER_LAYER; j += F.G) {
        const int jn = j + F.G;
        if (jn < CT_PER_LAYER) ld(jn, nxt);
        st(j, cur);
#pragma unroll
        for (int a = 0; a < 4; ++a)
#pragma unroll
            for (int r = 0; r < 4; ++r) cur[a][r] = nxt[a][r];
    }
}
__device__ __forceinline__ int spare_units(int nwg, int G, int c) { const int mx = (nwg + G - 1) / G, mine = c < nwg ? (nwg - c + G - 1) / G : 0; return mx - mine; }
__device__ __forceinline__ void prologue_moe(const Frame& F) {
    const int gw = F.blk * NWAVES + F.wave, NGW = F.G * NWAVES, lane = lane_id();
    {
        LAS float* scr = (LAS float*)(F.lds + F.wave * 16384);
        if (MOE_FP8) {
            __syncthreads();
            constexpr int PER_GU = (D / 128) * (2048 / 256), PER_DN = (D / 128) * (D / 256), N_GU = DEPTH * NE * PER_GU, NIT = CT_PER_LAYER;
            const DestGu dg; const DestId di;
            LAS unsigned* L = (LAS unsigned*)F.lds;
            f32x4 cur[4][4], nxt[4][4];
            auto ld = [&](int itl, f32x4 (&v)[4][4]) { const int it = ct_global(0, itl);
                if (it < N_GU) { const int le = it / PER_GU, r = it % PER_GU; t8b_load(F.w_gu + (size_t)le * D * 2048, 2048, 128 * (r >> 3), 256 * (r & 7), F.wave, lane, v); }
                else { const int q = it - N_GU, le = q / PER_DN, r = q % PER_DN; t8b_load(F.w_down + (size_t)le * D * D, D, 128 * (r >> 2), 256 * (r & 3), F.wave, lane, v); } };
            auto st = [&](int itl, const f32x4 (&v)[4][4]) { const int it = ct_global(0, itl);
                if (it < N_GU) { const int le = it / PER_GU, r = it % PER_GU; t8b_store(v, D, WSP(unsigned char, WS_WGU) + (size_t)le * 2048 * D, dg, 128 * (r >> 3), 256 * (r & 7), L, F.wave, lane, WSCALE); }
                else { const int q = it - N_GU, le = q / PER_DN, r = q % PER_DN; t8b_store(v, D, WSP(unsigned char, WS_WDN) + (size_t)le * D * D, di, 128 * (r >> 2), 256 * (r & 3), L, F.wave, lane, WSCALE); } };
            int it = F.blk;
            if (it < NIT) ld(it, cur);
#pragma unroll 1
            for (; it < NIT; it += F.G) {
                const int itn = it + F.G;
                if (itn < NIT) ld(itn, nxt);
                st(it, cur);
#pragma unroll
                for (int j = 0; j < 4; ++j)
#pragma unroll
                    for (int r = 0; r < 4; ++r) cur[j][r] = nxt[j][r];
            }
        } else {
            { constexpr int PER = (D / 64) * (2048 / 32); const DestGu dg;
              for (int it = gw; it < DEPTH * NE * PER; it += NGW) { const int le = it / PER; transpose_item(F.w_gu + (size_t)le * D * 2048, D, 2048, WSP(bf16, WS_WGU) + (size_t)le * 2048 * D, dg, scr, it % PER, lane); } }
            { constexpr int PER = (D / 64) * (D / 32); const DestId di;
              for (int it = gw; it < DEPTH * NE * PER; it += NGW) { const int le = it / PER; transpose_item(F.w_down + (size_t)le * D * D, D, D, WSP(bf16, WS_WDN) + (size_t)le * D * D, di, scr, it % PER, lane); } }
        }
    }
}
__device__ __forceinline__ void phase_prologue(const Frame& F) {
    if (F.blk & 1) { prologue_moe(F); __syncthreads(); prologue_small(F); }
    else { prologue_small(F); __syncthreads(); prologue_moe(F); }
}

template <int MODEK>
__device__ __forceinline__ void phase_tokA(const Frame& F, const void* xsrc, bool src_f32, bool combine, bool writex, const float* modl_prev_g2, const float* gvec, const float* modl_sh, const float* modl_sc) {
    const int lane = lane_id(), t0 = F.blk * TPB + F.wave * (TPB / NWAVES), b = (F.blk * TPB) / S;
    void* X = WSP(void, WS_X); bf16* H = WSP(bf16, WS_H); const bf16* Y = WSP(bf16, WS_Y); const int* tokrow = WSP(int, WS_TOKROW);
    f32x4 scl[4], shf[4], g2v[4];
#pragma unroll
    for (int j = 0; j < 4; ++j) {
        const int ci = 64 * j + lane;
        scl[j] = ((const f32x4*)gvec)[ci]; shf[j] = (f32x4){0.f, 0.f, 0.f, 0.f}; g2v[j] = (f32x4){0.f, 0.f, 0.f, 0.f};
        if (MODEK == 1) { scl[j] = scl[j] * (((const f32x4*)(modl_sc + (size_t)b * 6 * D))[ci] + 1.f); shf[j] = ((const f32x4*)(modl_sh + (size_t)b * 6 * D))[ci]; }
        if (combine) g2v[j] = ((const f32x4*)(modl_prev_g2 + (size_t)b * 6 * D))[ci] * (Y_FP8 ? 1.f / YSCALE : 1.f);
    }
    static_assert(Y_FP8 && X_BF16, "pipelined token phase: fp8 Y rows, bf16 X");
    u32x4 xr[4]; unsigned yr[4][4]; int rn[4];
    auto issue = [&](int t, const int (&rows)[4]) {
#pragma unroll
        for (int j = 0; j < 4; ++j) {
            if (src_f32) xr[j] = *(const u32x4*)((const float*)xsrc + (size_t)t * D + 256 * j + 4 * lane);
            else { const u32x2 w = *(const u32x2*)((const unsigned short*)xsrc + (size_t)t * D + 256 * j + 4 * lane); xr[j] = (u32x4){w.x, w.y, 0u, 0u}; }
        }
        if (combine) {
#pragma unroll
            for (int k = 0; k < 4; ++k) { const unsigned* yp = (const unsigned*)((const unsigned char*)Y + (size_t)rows[k] * D);
#pragma unroll
                for (int j = 0; j < 4; ++j) yr[k][j] = yp[64 * j + lane]; }
        }
    };
    {
        int r0[4];
#pragma unroll
        for (int k = 0; k < 4; ++k) { r0[k] = combine ? tokrow[t0 * 4 + k] : 0; rn[k] = combine ? tokrow[(t0 + 1) * 4 + k] : 0; }
        issue(t0, r0);
    }
#pragma unroll 1
    for (int i = 0; i < TPB / NWAVES; ++i) {
        const int t = t0 + i;
        u32x4 xc[4]; unsigned yc[4][4];
#pragma unroll
        for (int j = 0; j < 4; ++j) { xc[j] = xr[j];
#pragma unroll
            for (int k = 0; k < 4; ++k) yc[k][j] = yr[k][j]; }
        if (i + 1 < TPB / NWAVES) {
            int rc[4];
#pragma unroll
            for (int k = 0; k < 4; ++k) rc[k] = rn[k];
            issue(t + 1, rc);
            const int t2 = min(t + 2, T - 1);
#pragma unroll
            for (int k = 0; k < 4; ++k) rn[k] = combine ? tokrow[t2 * 4 + k] : 0;
        }
        f32x4 xv[4];
#pragma unroll
        for (int j = 0; j < 4; ++j) xv[j] = src_f32 ? __builtin_bit_cast(f32x4, xc[j]) : (f32x4){bflo(xc[j].x), bfhi(xc[j].x), bflo(xc[j].y), bfhi(xc[j].y)};
        if (combine) {
            f32x4 a[4];
#pragma unroll
            for (int j = 0; j < 4; ++j) a[j] = (f32x4){0.f, 0.f, 0.f, 0.f};
#pragma unroll
            for (int k = 0; k < 4; ++k) {
#pragma unroll
                for (int j = 0; j < 4; ++j) { const unsigned w = yc[k][j]; const auto lo = __builtin_amdgcn_cvt_pk_f32_fp8((int)w, false), hi = __builtin_amdgcn_cvt_pk_f32_fp8((int)w, true); a[j] += (f32x4){lo[0], lo[1], hi[0], hi[1]}; }
            }
#pragma unroll
            for (int j = 0; j < 4; ++j) xv[j] += g2v[j] * a[j];
        }
        if (writex) {
#pragma unroll
            for (int j = 0; j < 4; ++j) xstore4(X, (size_t)t * D + 256 * j + 4 * lane, xv[j]);
        }
        if (MODEK != 0) {
            float ss = 0.f;
#pragma unroll
            for (int j = 0; j < 4; ++j) ss += (xv[j][0] * xv[j][0] + xv[j][1] * xv[j][1]) + (xv[j][2] * xv[j][2] + xv[j][3] * xv[j][3]);
            const float r = rsqrtf(wave_sum(ss) * KF(1.f / D) + KF(EPS));
#pragma unroll
            for (int j = 0; j < 4; ++j) {
                const f32x4 hv = xv[j] * r * scl[j] + shf[j];
                if (MODEK == 1) {
                    if (B_FP8) ((unsigned*)(WSP(unsigned char, WS_H8) + (size_t)t * D))[64 * j + lane] = pk4_fp8(hv[0] * HSCALE, hv[1] * HSCALE, hv[2] * HSCALE, hv[3] * HSCALE);
                    else { u32x2 w; w.x = pk2(hv[0], hv[1]); w.y = pk2(hv[2], hv[3]); ((u32x2*)(H + (size_t)t * D))[64 * j + lane] = w; } }
                else ((f32x4*)(F.out + (size_t)t * D))[64 * j + lane] = hv;
            }
        }
    }
}

constexpr int HB_PITCH = D + 4;
__device__ __forceinline__ void phase_tokH(const Frame& F, int l) {
    typedef float f32x4_t __attribute__((ext_vector_type(4)));
    const int lane = lane_id(), tid = F.wave * 64 + lane, wave = F.wave, b = (F.blk * TPB) / S;
    const void* X = WSP(void, WS_X); bf16* H = WSP(bf16, WS_H);
    int* tope = WSP(int, WS_TOPE); float* topg = WSP(float, WS_TOPG); int* lrank = WSP(int, WS_LRANK); int* hist = WSP(int, WS_HIST);
    LAS float* hbuf = (LAS float*)F.lds;
    LAS float* part = (LAS float*)(F.lds + 16 * HB_PITCH * 4);
    LAS int* lhist = (LAS int*)(F.lds + MISC_OFF + 256);
    if (tid < NE) lhist[tid] = 0;
    const float* rwt = WSP(float, WS_RWT) + (size_t)l * NE * D;
    f32x4 Bw[8][2];
#pragma unroll
    for (int s8 = 0; s8 < 8; ++s8)
#pragma unroll
        for (int eh = 0; eh < 2; ++eh) Bw[s8][eh] = *(const f32x4*)(rwt + (size_t)(eh * 16 + (lane & 15)) * D + wave * 128 + 16 * s8 + 4 * (lane >> 4));
    const float* modl = WSP(float, WS_MOD) + (size_t)l * NB * 6 * D + (size_t)b * 6 * D;
    f32x4 scl[4], shf[4];
#pragma unroll
    for (int j = 0; j < 4; ++j) { const int ci = 64 * j + lane; scl[j] = ((const f32x4*)(F.norm2_g + l * D))[ci] * (((const f32x4*)(modl + 4 * D))[ci] + 1.f); shf[j] = ((const f32x4*)(modl + 3 * D))[ci]; }
    const float rbias = F.router_b[l * NE + (lane & 31)];
    __syncthreads();
#pragma unroll 1
    for (int c = 0; c < TPB / 16; ++c) {
#pragma unroll
        for (int tt = 0; tt < 2; ++tt) {
            const int tl = wave * 2 + tt, t = F.blk * TPB + c * 16 + tl;
            f32x4 xv[4]; float ss = 0.f;
#pragma unroll
            for (int j = 0; j < 4; ++j) { xv[j] = xload4(X, (size_t)t * D + 256 * j + 4 * lane, false); ss += (xv[j][0] * xv[j][0] + xv[j][1] * xv[j][1]) + (xv[j][2] * xv[j][2] + xv[j][3] * xv[j][3]); }
            const float r = rsqrtf(wave_sum(ss) * KF(1.f / D) + KF(EPS));
#pragma unroll
            for (int j = 0; j < 4; ++j) {
                const f32x4 h4 = xv[j] * r * scl[j] + shf[j];
                if (MOE_FP8) ((unsigned*)(WSP(unsigned char, WS_H8) + (size_t)t * D))[64 * j + lane] = pk4_fp8(h4[0] * HSCALE, h4[1] * HSCALE, h4[2] * HSCALE, h4[3] * HSCALE);
                else { u32x2 w; w.x = pk2(h4[0], h4[1]); w.y = pk2(h4[2], h4[3]); ((u32x2*)(H + (size_t)t * D))[64 * j + lane] = w; }
                *(LAS f32x4*)(hbuf + tl * HB_PITCH + 256 * j + 4 * lane) = h4;
            }
        }
        __syncthreads();
        {
            f32x4 acc0 = {0.f, 0.f, 0.f, 0.f}, acc1 = {0.f, 0.f, 0.f, 0.f};
            const LAS float* ap = hbuf + (lane & 15) * HB_PITCH + wave * 128 + 4 * (lane >> 4);
#pragma unroll
            for (int s8 = 0; s8 < 8; ++s8) {
                const f32x4 a = *(const LAS f32x4*)(ap + 16 * s8);
#pragma unroll
                for (int i = 0; i < 4; ++i) {
                    acc0 = __builtin_amdgcn_mfma_f32_16x16x4f32(a[i], Bw[s8][0][i], acc0, 0, 0, 0);
                    acc1 = __builtin_amdgcn_mfma_f32_16x16x4f32(a[i], Bw[s8][1][i], acc1, 0, 0, 0);
                }
            }
            LAS float* pp = part + wave * 512 + (4 * (lane >> 4)) * 32 + (lane & 15);
#pragma unroll
            for (int q = 0; q < 4; ++q) { pp[q * 32] = acc0[q]; pp[q * 32 + 16] = acc1[q]; }
        }
        __syncthreads();
        {
            const int tl = wave * 2 + (lane >> 5), e = lane & 31, t = F.blk * TPB + c * 16 + tl;
            float logit = rbias;
#pragma unroll
            for (int w = 0; w < NWAVES; ++w) logit += part[w * 512 + tl * 32 + e];
            float vals[4]; int idx[4];
#pragma unroll
            for (int k = 0; k < 4; ++k) {
                float m = logit; int mi = e;
#pragma unroll
                for (int o = 1; o < 32; o <<= 1) { const float om = __shfl_xor(m, o); const int oi = __shfl_xor(mi, o); if (om > m || (om == m && oi < mi)) { m = om; mi = oi; } }
                vals[k] = m; idx[k] = mi; if (e == mi) logit = KF(-3.0e38f);
            }
            const float e1 = fexp(vals[1] - vals[0]), e2 = fexp(vals[2] - vals[0]), e3 = fexp(vals[3] - vals[0]);
            const float inv = 1.f / (1.f + e1 + e2 + e3);
            if (e < 4) {
                const int myi = e == 0 ? idx[0] : (e == 1 ? idx[1] : (e == 2 ? idx[2] : idx[3]));
                const float myg = (e == 0 ? 1.f : (e == 1 ? e1 : (e == 2 ? e2 : e3))) * inv;
                tope[t * 4 + e] = myi; topg[t * 4 + e] = myg;
                lrank[t * 4 + e] = __hip_atomic_fetch_add(lhist + myi, 1, __ATOMIC_RELAXED, __HIP_MEMORY_SCOPE_WORKGROUP);
            }
        }
    }
    __syncthreads();
    if (tid < NE) hist[F.blk * NE + tid] = lhist[tid];
    __syncthreads();
}

__device__ __forceinline__ void phase_route(const Frame& F) {
    const int tid = F.wave * 64 + lane_id();
    const int* hist = WSP(int, WS_HIST); const int* tope = WSP(int, WS_TOPE); const float* topg = WSP(float, WS_TOPG); const int* lrank = WSP(int, WS_LRANK);
    int* rowtok = WSP(int, WS_ROWTOK); float* rowgate = WSP(float, WS_ROWGATE); int* tokrow = WSP(int, WS_TOKROW); int* tileexp = WSP(int, WS_TILEEXP);
    LAS int* tp = (LAS int*)F.lds; LAS int* pp = tp + 512; LAS int* tot = pp + 512; LAS int* pre = tot + 32; LAS int* base = pre + 32;
    {
        const int e = tid & 31, part = tid >> 5; int a = 0, p = 0;
        for (int q = 0; q < GRID / 16; ++q) { const int bb = part * (GRID / 16) + q; const int v = hist[bb * NE + e]; a += v; p += (bb < F.blk) ? v : 0; }
        tp[part * 32 + e] = a; pp[part * 32 + e] = p;
    }
    __syncthreads();
    if (tid < NE) { int a = 0, p = 0; for (int q = 0; q < 16; ++q) { a += tp[q * 32 + tid]; p += pp[q * 32 + tid]; } tot[tid] = a; pre[tid] = p; }
    __syncthreads();
    if (tid == 0) { int s = 0; for (int e = 0; e < NE; ++e) { base[e] = s; s += (tot[e] + RPAD - 1) / RPAD * RPAD; } base[NE] = s; }
    __syncthreads();
    {
        const int a = F.blk * (TPB * TOPK) + tid;
        const int e = tope[a]; const int row = base[e] + pre[e] + lrank[a];
        rowtok[row] = a >> 2; rowgate[row] = topg[a]; tokrow[a] = row;
    }
    if (F.blk < NE) {
        const int e = F.blk;
        for (int r = base[e] + tot[e] + tid; r < base[e + 1]; r += NTHREADS) { rowtok[r] = 0; rowgate[r] = 0.f; }
        for (int tl = base[e] / RPAD + tid; tl < base[e + 1] / RPAD; tl += NTHREADS) tileexp[tl] = e;
    }
    if (F.blk == 0 && tid == 0) tileexp[NRT_SLOT] = base[NE] / RPAD;
    __syncthreads();
}

__device__ __forceinline__ unsigned kv_off(unsigned row, unsigned ch) { const unsigned f = (((row >> 1) & 1u) << 2) | (((row >> 2) & 1u) << 1) | ((row >> 3) & 1u); return row * 128u + ((ch ^ f) << 4); }
__device__ __forceinline__ int crow(int reg, int h) { return (reg & 3) + 8 * (reg >> 2) + 4 * h; }

__device__ __forceinline__ void phase_attn_pool(const Frame& F) {
    const int lane = lane_id(), tid = F.wave * 64 + lane, wave = F.wave, half = wave >> 2, w4 = wave & 3, th = tid & 255;
    const int r5 = lane & 31, h = lane >> 5, blk16 = (lane >> 4) & 1, q4 = (lane & 15) >> 2, p4 = lane & 3;
    const bf16* Qb = WSP(bf16, WS_Q); const bf16* Kb = WSP(bf16, WS_K); const bf16* Vb = WSP(bf16, WS_V);
    bf16* OG = WSP(bf16, WS_OG); float* LSE = WSP(float, WS_LSE);
    LAS unsigned char* Kimg = F.lds + half * 65536; LAS unsigned char* Vimg = Kimg + 32768;
    constexpr float SC = 0.18033688011112042f;
    constexpr int NSUB = NB * 12 * 16;
    u32x4 kr[8], vr[8];
    auto stage_load = [&](int pr_) {
        const int su = pr_ * 2 + half; const int rb = su & 15, bgh = su >> 4, gh = bgh % 12, b = bgh / 12, g = gh >> 2;
        const int dil = (g == 0) ? 1 : (g == 1 ? 4 : 16), L = S / dil, nblk = L / 128; const int r = rb / nblk, qblk = rb % nblk, kb0 = qblk * 128 - 64;
#pragma unroll
        for (int p = 0; p < 8; ++p) {
            const int idx = p * 256 + th, row = idx >> 3, ch = idx & 7, key = kb0 + row;
            if (key >= 0 && key < L) { const size_t go = (size_t)(b * S + key * dil + r) * 768 + gh * 64 + ch * 8; kr[p] = *(const u32x4*)(Kb + go); vr[p] = *(const u32x4*)(Vb + go); }
            else { kr[p] = (u32x4){0u, 0u, 0u, 0u}; vr[p] = kr[p]; }
        }
    };
    if (F.blk < NSUB / 2) stage_load(F.blk);
    for (int pr = F.blk; pr < NSUB / 2; pr += F.G) {
        const int su = pr * 2 + half;
        const int rb = su & 15, bgh = su >> 4, gh = bgh % 12, b = bgh / 12, g = gh >> 2;
        const int dil = (g == 0) ? 1 : (g == 1 ? 4 : 16), L = S / dil, nblk = L / 128;
        const int r = rb / nblk, qblk = rb % nblk;
        __syncthreads();
#pragma unroll
        for (int p = 0; p < 8; ++p) {
            const int idx = p * 256 + th, row = idx >> 3, ch = idx & 7; const unsigned o = kv_off(row, ch);
            *(LAS u32x4*)(Kimg + o) = kr[p]; *(LAS u32x4*)(Vimg + o) = vr[p];
        }
        const int m0 = qblk * 128 + w4 * 32;
        const int tq = b * S + (m0 + r5) * dil + r;
        bf16x8 qf[4];
#pragma unroll
        for (int ks = 0; ks < 4; ++ks) qf[ks] = *(const bf16x8*)(Qb + (size_t)tq * 768 + gh * 64 + 16 * ks + 8 * h);
        asm volatile("s_waitcnt lgkmcnt(0)" ::: "memory");
        if (pr + F.G < NSUB / 2) stage_load(pr + F.G);
        __syncthreads();
        float m_run = -1e30f, l_run = 0.f;
        f32x16 o0, o1;
#pragma unroll
        for (int e = 0; e < 16; ++e) { o0[e] = 0.f; o1[e] = 0.f; }
        for (int it = 0; it < 5; ++it) {
            const int kt = m0 - 64 + 32 * it;
            if (kt < 0 || kt >= L) continue;
            const unsigned lrow0 = (unsigned)(w4 * 32 + 32 * it);
            f32x16 s;
#pragma unroll
            for (int e = 0; e < 16; ++e) s[e] = 0.f;
#pragma unroll
            for (int ks = 0; ks < 4; ++ks) {
                const bf16x8 a = *(const LAS bf16x8*)(Kimg + kv_off(lrow0 + r5, 2 * ks + h));
                s = __builtin_amdgcn_mfma_f32_32x32x16_bf16(a, qf[ks], s, 0, 0, 0);
            }
            if (it == 0) {
#pragma unroll
                for (int e = 0; e < 16; ++e) if (crow(e, h) < r5) s[e] = -1e30f;
            }
            if (it == 4) {
#pragma unroll
                for (int e = 0; e < 16; ++e) if (crow(e, h) > r5) s[e] = -1e30f;
            }
            float mx = s[0];
#pragma unroll
            for (int e = 1; e < 16; ++e) mx = fmaxf(mx, s[e]);
            mx = fmaxf(mx, __shfl_xor(mx, 32));
            const float m_new = fmaxf(m_run, mx), alpha = __builtin_amdgcn_exp2f((m_run - m_new) * SC);
            m_run = m_new;
            float psum = 0.f;
#pragma unroll
            for (int e = 0; e < 16; ++e) { const float p = __builtin_amdgcn_exp2f((s[e] - m_new) * SC); s[e] = p; psum += p; }
            l_run = l_run * alpha + psum;
#pragma unroll
            for (int e = 0; e < 16; ++e) { o0[e] *= alpha; o1[e] *= alpha; }
            bf16x8 pb[2];
#pragma unroll
            for (int st = 0; st < 2; ++st) { u32x4 w; w.x = pk2(s[8 * st], s[8 * st + 1]); w.y = pk2(s[8 * st + 2], s[8 * st + 3]); w.z = pk2(s[8 * st + 4], s[8 * st + 5]); w.w = pk2(s[8 * st + 6], s[8 * st + 7]); pb[st] = __builtin_bit_cast(bf16x8, w); }
            s16x4 vt[2][2][2];
            {
                unsigned ad[2][2][2];
#pragma unroll
                for (int c = 0; c < 2; ++c)
#pragma unroll
                    for (int st = 0; st < 2; ++st)
#pragma unroll
                        for (int tt = 0; tt < 2; ++tt)
                            ad[c][st][tt] = (unsigned)(size_t)Vimg + kv_off(lrow0 + 16 * st + 8 * tt + 4 * h + q4, 4 * c + 2 * blk16 + (p4 >> 1)) + 8 * (p4 & 1);
                asm volatile("ds_read_b64_tr_b16 %0, %8\n\tds_read_b64_tr_b16 %1, %9\n\tds_read_b64_tr_b16 %2, %10\n\tds_read_b64_tr_b16 %3, %11\n\t"
                             "ds_read_b64_tr_b16 %4, %12\n\tds_read_b64_tr_b16 %5, %13\n\tds_read_b64_tr_b16 %6, %14\n\tds_read_b64_tr_b16 %7, %15\n\ts_waitcnt lgkmcnt(0)"
                             : "=&v"(vt[0][0][0]), "=&v"(vt[0][0][1]), "=&v"(vt[0][1][0]), "=&v"(vt[0][1][1]), "=&v"(vt[1][0][0]), "=&v"(vt[1][0][1]), "=&v"(vt[1][1][0]), "=&v"(vt[1][1][1])
                             : "v"(ad[0][0][0]), "v"(ad[0][0][1]), "v"(ad[0][1][0]), "v"(ad[0][1][1]), "v"(ad[1][0][0]), "v"(ad[1][0][1]), "v"(ad[1][1][0]), "v"(ad[1][1][1])
                             : "memory");
            }
#pragma unroll
            for (int st = 0; st < 2; ++st) {
                const bf16x8 a0 = __builtin_shufflevector(vt[0][st][0], vt[0][st][1], 0, 1, 2, 3, 4, 5, 6, 7);
                const bf16x8 a1 = __builtin_shufflevector(vt[1][st][0], vt[1][st][1], 0, 1, 2, 3, 4, 5, 6, 7);
                o0 = __builtin_amdgcn_mfma_f32_32x32x16_bf16(a0, pb[st], o0, 0, 0, 0);
                o1 = __builtin_amdgcn_mfma_f32_32x32x16_bf16(a1, pb[st], o1, 0, 0, 0);
            }
        }
        const float l_tot = l_run + __shfl_xor(l_run, 32), inv_l = 1.f / l_tot;
        bf16* op = OG + (size_t)tq * 768 + gh * 64;
#pragma unroll
        for (int g4 = 0; g4 < 4; ++g4) {
            u32x2 w0, w1;
            w0.x = pk2(o0[4 * g4] * inv_l, o0[4 * g4 + 1] * inv_l); w0.y = pk2(o0[4 * g4 + 2] * inv_l, o0[4 * g4 + 3] * inv_l);
            w1.x = pk2(o1[4 * g4] * inv_l, o1[4 * g4 + 1] * inv_l); w1.y = pk2(o1[4 * g4 + 2] * inv_l, o1[4 * g4 + 3] * inv_l);
            *(u32x2*)(op + 8 * g4 + 4 * h) = w0; *(u32x2*)(op + 32 + 8 * g4 + 4 * h) = w1;
        }
        if (h == 0) LSE[(size_t)tq * 12 + gh] = m_run * 0.125f + flog(l_tot);
    }
    {
        const bf16* U = WSP(bf16, WS_U); bf16* AD = WSP(bf16, WS_AD);
        const int tseg = F.blk * TPB + wave * 16 + (lane >> 4) * 4, sseg = tseg & (S - 1), tb = tseg - sseg;
#define POOL_GROUP(G)                                                                                                                         \
        {   constexpr int HW = 1 << (G), NR = 2 * HW + 4; const int ch = (G) * 16 + (lane & 15);                                                \
            u32x4 rw[NR];                                                                                                                       \
            _Pragma("unroll") for (int q = 0; q < NR; ++q) { const int p = sseg - HW + q; const bool ok = (p >= 0) && (p < S);                  \
                rw[q] = ok ? *(const u32x4*)(U + (size_t)(tb + p) * 512 + ch * 8) : (u32x4){0u, 0u, 0u, 0u}; }                                  \
            float a[8];                                                                                                                         \
            _Pragma("unroll") for (int e = 0; e < 8; ++e) a[e] = 0.f;                                                                           \
            _Pragma("unroll") for (int q = 0; q < 2 * HW; ++q) { a[0] += bflo(rw[q].x); a[1] += bfhi(rw[q].x); a[2] += bflo(rw[q].y); a[3] += bfhi(rw[q].y); \
                a[4] += bflo(rw[q].z); a[5] += bfhi(rw[q].z); a[6] += bflo(rw[q].w); a[7] += bfhi(rw[q].w); }                                   \
            _Pragma("unroll") for (int i = 0; i < 4; ++i) {                                                                                     \
                const int s = sseg + i; const float inv = 1.f / (float)(min(s + HW, S) - max(s - HW, 0)); const u32x4 w = rw[HW + i]; u32x4 o;   \
                o.x = pk2(a[0] * inv - bflo(w.x), a[1] * inv - bfhi(w.x)); o.y = pk2(a[2] * inv - bflo(w.y), a[3] * inv - bfhi(w.y));            \
                o.z = pk2(a[4] * inv - bflo(w.z), a[5] * inv - bfhi(w.z)); o.w = pk2(a[6] * inv - bflo(w.w), a[7] * inv - bfhi(w.w));            \
                *(u32x4*)(AD + (size_t)(tseg + i) * 768 + 256 + ch * 8) = o;                                                                     \
                if (i < 3) { const u32x4 pl = rw[2 * HW + i], mi = rw[i];                                                                        \
                    a[0] += bflo(pl.x) - bflo(mi.x); a[1] += bfhi(pl.x) - bfhi(mi.x); a[2] += bflo(pl.y) - bflo(mi.y); a[3] += bfhi(pl.y) - bfhi(mi.y); \
                    a[4] += bflo(pl.z) - bflo(mi.z); a[5] += bfhi(pl.z) - bfhi(mi.z); a[6] += bflo(pl.w) - bflo(mi.w); a[7] += bfhi(pl.w) - bfhi(mi.w); } \
            }                                                                                                                                   \
        }
        POOL_GROUP(0) POOL_GROUP(1) POOL_GROUP(2) POOL_GROUP(3)
#undef POOL_GROUP
    }
}

__device__ __forceinline__ void phase_attn_combine(const Frame& F) {
    const bf16* OG = WSP(bf16, WS_OG); const float* LSE = WSP(float, WS_LSE); bf16* AD = WSP(bf16, WS_AD);
    const int lane = lane_id(), hh = lane >> 4, d0 = (lane & 15) * 4;
#pragma unroll 2
    for (int i = 0; i < TPB / NWAVES; ++i) {
        const int t = F.blk * TPB + F.wave * (TPB / NWAVES) + i;
        const float l0 = LSE[(size_t)t * 12 + hh], l1 = LSE[(size_t)t * 12 + 4 + hh], l2 = LSE[(size_t)t * 12 + 8 + hh];
        const float m = fmaxf(l0, fmaxf(l1, l2)), e0 = fexp(l0 - m), e1 = fexp(l1 - m), e2 = fexp(l2 - m), inv = 1.f / (e0 + e1 + e2);
        const u32x2 a = *(const u32x2*)(OG + (size_t)t * 768 + hh * 64 + d0), bq = *(const u32x2*)(OG + (size_t)t * 768 + (4 + hh) * 64 + d0), c = *(const u32x2*)(OG + (size_t)t * 768 + (8 + hh) * 64 + d0);
        const float w0 = e0 * inv, w1 = e1 * inv, w2 = e2 * inv;
        u32x2 o;
        o.x = pk2(w0 * bflo(a.x) + w1 * bflo(bq.x) + w2 * bflo(c.x), w0 * bfhi(a.x) + w1 * bfhi(bq.x) + w2 * bfhi(c.x));
        o.y = pk2(w0 * bflo(a.y) + w1 * bflo(bq.y) + w2 * bflo(c.y), w0 * bfhi(a.y) + w1 * bfhi(bq.y) + w2 * bfhi(c.y));
        *(u32x2*)(AD + (size_t)t * 768 + hh * 64 + d0) = o;
    }
}

constexpr int PH_PER_LAYER = 11, PH_FINAL = 1 + DEPTH * PH_PER_LAYER, NPHASE = PH_FINAL + 1;

__global__ void __launch_bounds__(NTHREADS, 2) mega_fwd(Args args) {
    extern __shared__ __attribute__((aligned(16))) unsigned char lds_raw[];
    LAS unsigned char* const lds0 = (LAS unsigned char*)lds_raw; const int wave0 = __builtin_amdgcn_readfirstlane((int)threadIdx.x >> 6);
#define MKF const Frame F = make_frame(kargs(), lds0, wave0)
    volatile LAS unsigned* MISC = (volatile LAS unsigned*)(lds0 + MISC_OFF);
    for (int u = threadIdx.x; u < (LDS_BYTES - MISC_OFF) / 4; u += NTHREADS) ((LAS unsigned*)(lds0 + MISC_OFF))[u] = 0u;
#if MODE != 0
    for (int u = threadIdx.x; u < MISC_OFF / 4; u += NTHREADS) ((LAS unsigned*)lds0)[u] = (args.flags & 16) ? 0x3f803f80u : 0xFFFFFFFFu;
#endif
    __syncthreads();
    unsigned* ctl = (unsigned*)(args.ws + WS_CTL);
    XcdBarrier bar = xcd_barrier_post(ctl + CW_BAR + args.li * BAR_REGION_WORDS, MISC + 8, threadIdx.x == 0);
    const int lo = args.ph_lo, hi = args.ph_hi;
    const bool nocomb = (args.flags & 1) != 0;
#define IN(k) (lo <= (k) && (k) < hi)
#define SEAM(k) do { if (IN(k) && IN((k) + 1)) xcd_barrier(bar, wave0 == 0 && lane_id() == 0); } while (0)

    if (IN(0)) { REP(-2) { MKF; phase_prologue(F); } SEAM(0); }
    for (int l = 0; l < DEPTH; ++l) {
        const int pb = 1 + l * PH_PER_LAYER;
        if (IN(pb + 0)) {
            REP(0) {
            MKF; void* X = WSP(void, WS_X); const float* modl = WSP(float, WS_MOD) + (size_t)l * NB * 6 * D;
            const bool comb = (l > 0) && !nocomb; const bool first = (l == 0 && !nocomb);
            phase_tokA<1>(F, first ? (const void*)F.x_in : (const void*)X, first, comb, comb, modl - (size_t)NB * 6 * D + 5 * D, F.norm1_g + l * D, modl + 0 * D, modl + 1 * D);
            }
            SEAM(pb + 0);
        }
        if (IN(pb + 1)) {
            REP(1) {
            MKF;
            DenseSched Sd; Sd.so.init(T / BM, IN_COLS / BM, F.G, F.blk, false, 4); constexpr int BB = B_FP8 ? 1 : 2;
            Sd.A = B_FP8 ? (const char*)WSP(unsigned char, WS_H8) : (const char*)WSP(bf16, WS_H); Sd.Bt = (const char*)WSP(unsigned char, WS_WIN) + (size_t)l * IN_COLS * D * BB; Sd.lda = D * BB / 2; Sd.K = D * BB / 2;
            EpiProj E{WSP(bf16, WS_Q), WSP(bf16, WS_K), WSP(bf16, WS_V), WSP(bf16, WS_U), WSP(bf16, WS_GA), WSP(bf16, WS_GP), WSP(float, WS_ROPE)};
            gemm_phase<EpiProj, DenseSched, true, B_FP8 != 0>(F.lds, D * BB / 2, Sd, E, F.wave);
            if (MOE_FP8) tail_convert(F, l < 1 ? 1 : l, TAIL_B * spare_units((T / BM) * (IN_COLS / BM), F.G, F.blk));
            }
            SEAM(pb + 1);
        }
        if (IN(pb + 2)) { REP(2) { MKF; phase_attn_pool(F); } SEAM(pb + 2); }
        if (IN(pb + 3)) {
            REP(3) {
            MKF; phase_attn_combine(F);
            DenseSched Sd; Sd.so.init(T / BM, D / BM, F.G, F.blk); Sd.A = (const char*)(WSP(bf16, WS_AD) + 256); Sd.Bt = (const char*)(WSP(bf16, WS_WP) + (size_t)l * D * 512); Sd.lda = 768; Sd.K = 512;
            EpiGate E{WSP(bf16, WS_GP), WSP(bf16, WS_MA)};
            __syncthreads();
            gemm_phase<EpiGate, DenseSched, true>(F.lds, 512, Sd, E, F.wave);
            }
            SEAM(pb + 3);
        }
        if (IN(pb + 4)) {
            REP(4) {
            MKF;
            DenseSched Sd; Sd.so.init(T / BM, D / BM, F.G, F.blk); Sd.A = (const char*)WSP(bf16, WS_AD); Sd.Bt = (const char*)(WSP(bf16, WS_WA) + (size_t)l * D * 256); Sd.lda = 768; Sd.K = 256;
            EpiGateAdd E{WSP(bf16, WS_GA), WSP(bf16, WS_MA), WSP(bf16, WS_MG)};
            gemm_phase<EpiGateAdd, DenseSched, true>(F.lds, 256, Sd, E, F.wave);
            }
            SEAM(pb + 4);
        }
        if (IN(pb + 6)) {
            REP(6) {
            MKF; void* X = WSP(void, WS_X); const float* modl = WSP(float, WS_MOD) + (size_t)l * NB * 6 * D; const bool first = (l == 0 && !nocomb);
            DenseSched Sd; Sd.so.init(T / BM, D / BM, F.G, F.blk); constexpr int GB = G_FP8 ? 1 : 2;
            Sd.A = (const char*)WSP(bf16, WS_MG); Sd.Bt = (const char*)WSP(unsigned char, WS_WOUT) + (size_t)l * D * D * GB; Sd.lda = D * GB / 2; Sd.K = D * GB / 2;
            EpiXres E{first ? (const void*)F.x_in : (const void*)X, X, modl + 2 * D, first};
            gemm_phase<EpiXres, DenseSched, true, G_FP8 != 0>(F.lds, D * GB / 2, Sd, E, F.wave);
            }
            SEAM(pb + 6);
        }
        if (IN(pb + 7)) { REP(7) { MKF; phase_tokH(F, l); } SEAM(pb + 7); }
        if (IN(pb + 8)) { REP(8) { MKF; phase_route(F); if (MOE_FP8 && l > 0) { if (DRAIN_STATIC) drain_static(F, l); else drain_convert(F, l); } } SEAM(pb + 8); }
        if (IN(pb + 9)) {
            REP(9) {
            MKF;
            const int* tileexp = WSP(int, WS_TILEEXP); const int nrt = tileexp[NRT_SLOT];
            MoeSched<true> Sm; Sm.so.init(nrt, 8, F.G, F.blk); Sm.A = MOE_FP8 ? (const char*)WSP(unsigned char, WS_H8) : (const char*)WSP(bf16, WS_H); Sm.Bt = (const char*)WSP(unsigned char, WS_WGU) + (size_t)l * NE * 2048 * D * EB; Sm.lda = D * EB / 2; Sm.K = D * EB / 2;
            Sm.estride = (size_t)2048 * D * EB; Sm.tile_exp = tileexp; Sm.row_token = WSP(int, WS_ROWTOK);
            EpiSwiglu E{WSP(bf16, WS_ACT), F.b_gu + (size_t)l * NE * 2048, tileexp};
            gemm_phase<EpiSwiglu, MoeSched<true>, true, MOE_FP8 != 0>(F.lds, D * EB / 2, Sm, E, F.wave);
            if (MOE_FP8) tail_convert(F, l + 1, TAIL_J * spare_units(nrt * 8, F.G, F.blk));
            }
            SEAM(pb + 9);
        }
        if (IN(pb + 10)) {
            REP(10) {
            MKF;
            const int* tileexp = WSP(int, WS_TILEEXP); const int nrt = tileexp[NRT_SLOT];
            MoeSched<false> Sm; Sm.so.init(nrt, 4, F.G, F.blk, true, 16); Sm.A = (const char*)WSP(bf16, WS_ACT); Sm.Bt = (const char*)WSP(unsigned char, WS_WDN) + (size_t)l * NE * D * D * EB; Sm.lda = D * EB / 2; Sm.K = D * EB / 2;
            Sm.estride = (size_t)D * D * EB; Sm.tile_exp = tileexp; Sm.row_token = nullptr;
            EpiDown E{WSP(bf16, WS_Y), F.b_down + (size_t)l * NE * D, tileexp, WSP(float, WS_ROWGATE)};
            gemm_phase<EpiDown, MoeSched<false>, true, MOE_FP8 != 0>(F.lds, D * EB / 2, Sm, E, F.wave);
            if (MOE_FP8) tail_convert(F, l + 1, TAIL_K * spare_units(nrt * 4, F.G, F.blk));
            }
            SEAM(pb + 10);
        }
    }
    if (IN(PH_FINAL)) {
        MKF; void* X = WSP(void, WS_X); const float* mod = WSP(float, WS_MOD);
#if defined(EXTRA_PH)
        {
            const int l = DEPTH - 1; const float* modl = mod + (size_t)l * NB * 6 * D;
#if EXTRA_PH == 7
            phase_tokH(F, l);
#elif EXTRA_PH == 0
            phase_tokA<1>(F, X, false, true, false, modl + 5 * D, F.norm1_g + l * D, modl + 0 * D, modl + 1 * D);
#elif EXTRA_PH == 10
            { const int* tileexp = WSP(int, WS_TILEEXP); const int nrt = tileexp[NRT_SLOT];
              MoeSched<false> Sm; Sm.so.init(nrt, 4, F.G, F.blk, true, 16); Sm.A = (const char*)WSP(bf16, WS_ACT); Sm.Bt = (const char*)WSP(unsigned char, WS_WDN) + (size_t)l * NE * D * D * EB; Sm.lda = D * EB / 2; Sm.K = D * EB / 2;
              Sm.estride = (size_t)D * D * EB; Sm.tile_exp = tileexp; Sm.row_token = nullptr;
              EpiDown E{WSP(bf16, WS_Y), F.b_down + (size_t)l * NE * D, tileexp, WSP(float, WS_ROWGATE)};
              gemm_phase<EpiDown, MoeSched<false>, true, MOE_FP8 != 0>(F.lds, D * EB / 2, Sm, E, F.wave); }
#elif EXTRA_PH >= 300
            prologue_small(F, opaque_s(EXTRA_PH - 300));
#elif EXTRA_PH == 101
            prologue_small(F);
#elif EXTRA_PH == 102
            prologue_moe(F);
#elif EXTRA_PH == 100
            phase_prologue(F);
#elif EXTRA_PH == 9
            { const int* tileexp = WSP(int, WS_TILEEXP); const int nrt = tileexp[NRT_SLOT];
              MoeSched<true> Sm; Sm.so.init(nrt, 8, F.G, F.blk); Sm.A = MOE_FP8 ? (const char*)WSP(unsigned char, WS_H8) : (const char*)WSP(bf16, WS_H); Sm.Bt = (const char*)WSP(unsigned char, WS_WGU) + (size_t)l * NE * 2048 * D * EB; Sm.lda = D * EB / 2; Sm.K = D * EB / 2;
              Sm.estride = (size_t)2048 * D * EB; Sm.tile_exp = tileexp; Sm.row_token = WSP(int, WS_ROWTOK);
              EpiSwiglu E{WSP(bf16, WS_ACT), F.b_gu + (size_t)l * NE * 2048, tileexp};
              gemm_phase<EpiSwiglu, MoeSched<true>, true, MOE_FP8 != 0>(F.lds, D * EB / 2, Sm, E, F.wave); }
#endif
            xcd_barrier(bar, wave0 == 0 && lane_id() == 0);
        }
#endif
        const float* modl = mod + (size_t)(DEPTH - 1) * NB * 6 * D;
        if (args.flags & 2) phase_tokA<0>(F, X, false, true, true, mod + (size_t)(args.flags >> 8) * NB * 6 * D + 5 * D, F.final_g, nullptr, nullptr);
        else phase_tokA<2>(F, X, false, true, false, modl + 5 * D, F.final_g, nullptr, nullptr);
    }
#undef IN
#undef SEAM
}
}

#if MODE != 0
namespace nv {
using namespace mk;
constexpr int QOFF = 0, KOFF = 768, VOFF = 1536, UOFF = 2304, GAOFF = 2816, GPOFF = 3840;
__global__ void k_copy(const float* __restrict__ a, float* __restrict__ b, size_t n4) { size_t i = (size_t)blockIdx.x * blockDim.x + threadIdx.x; if (i < n4) ((float4*)b)[i] = ((const float4*)a)[i]; }
__global__ void k_mod(const float* __restrict__ c, const float* __restrict__ ada_w, const float* __restrict__ ada_b, float* __restrict__ mod) {
    __shared__ float cs[NB][64];
    const int l = blockIdx.y, j = blockIdx.x * 256 + threadIdx.x;
    float acc[NB];
#pragma unroll
    for (int b = 0; b < NB; ++b) acc[b] = 0.f;
    for (int k0 = 0; k0 < D; k0 += 64) {
        __syncthreads();
        for (int i = threadIdx.x; i < NB * 64; i += 256) { int b = i / 64, kk = i % 64; float v = c[b * D + k0 + kk]; cs[b][kk] = v / (1.f + expf(-v)); }
        __syncthreads();
        for (int kk = 0; kk < 64; ++kk) { float w = ada_w[((size_t)l * D + k0 + kk) * (6 * D) + j];
#pragma unroll
            for (int b = 0; b < NB; ++b) acc[b] += cs[b][kk] * w; }
    }
#pragma unroll
    for (int b = 0; b < NB; ++b) mod[((size_t)l * NB + b) * (6 * D) + j] = acc[b] + ada_b[l * 6 * D + j];
}
__global__ void k_rope_table(float* __restrict__ cs) {
    int i = blockIdx.x * blockDim.x + threadIdx.x; if (i >= S * 8) return;
    int s = i / 8, j = i % 8; float inv = (float)pow(500000.0, -(double)(2 * j) / 16.0); float ang = (float)s * inv;
    cs[s * 16 + j] = (float)cos((double)ang); cs[s * 16 + 8 + j] = (float)sin((double)ang);
}
__device__ __forceinline__ float wsum(float v) {
#pragma unroll
    for (int o = 32; o > 0; o >>= 1) v += __shfl_xor(v, o);
    return v; }
__device__ __forceinline__ float wmax(float v) {
#pragma unroll
    for (int o = 32; o > 0; o >>= 1) v = fmaxf(v, __shfl_xor(v, o));
    return v; }
__global__ void k_norm_mod(const float* __restrict__ x, const float* __restrict__ g, const float* __restrict__ sh, const float* __restrict__ sc, float* __restrict__ h) {
    __shared__ float red[4];
    const int t = blockIdx.x, b = t / S, tid = threadIdx.x;
    float4 v = ((const float4*)(x + (size_t)t * D))[tid];
    float ss = wsum(v.x * v.x + v.y * v.y + v.z * v.z + v.w * v.w);
    if ((tid & 63) == 0) red[tid >> 6] = ss;
    __syncthreads();
    float r = rsqrtf((red[0] + red[1] + red[2] + red[3]) * (1.f / D) + EPS);
    float4 gg = ((const float4*)g)[tid]; float4 o;
    if (sh) { float4 s1 = ((const float4*)(sc + (size_t)b * 6 * D))[tid], s0 = ((const float4*)(sh + (size_t)b * 6 * D))[tid];
        o.x = v.x * r * gg.x * (1.f + s1.x) + s0.x; o.y = v.y * r * gg.y * (1.f + s1.y) + s0.y; o.z = v.z * r * gg.z * (1.f + s1.z) + s0.z; o.w = v.w * r * gg.w * (1.f + s1.w) + s0.w;
    } else { o.x = v.x * r * gg.x; o.y = v.y * r * gg.y; o.z = v.z * r * gg.z; o.w = v.w * r * gg.w; }
    ((float4*)(h + (size_t)t * D))[tid] = o;
}
__global__ void k_rope(float* __restrict__ proj, const float* __restrict__ cs) {
    size_t i = (size_t)blockIdx.x * blockDim.x + threadIdx.x; if (i >= (size_t)T * 2 * 12 * 8) return;
    int j = i % 8; size_t r = i / 8; int hd = r % 12; r /= 12; int which = r % 2; int t = (int)(r / 2); int s = t % S;
    float* p = proj + (size_t)t * IN_COLS + (which ? KOFF : QOFF) + hd * 64;
    float c = cs[s * 16 + j], sn = cs[s * 16 + 8 + j]; float t1 = p[j], t2 = p[j + 8];
    p[j] = t1 * c - t2 * sn; p[j + 8] = t2 * c + t1 * sn;
}
__global__ void k_attn(const float* __restrict__ proj, float* __restrict__ outg, float* __restrict__ lse) {
    const int wid = threadIdx.x >> 6, lane = threadIdx.x & 63;
    const size_t item = (size_t)blockIdx.x * 4 + wid; const int gh = item % 12; const int t = (int)(item / 12);
    const int g = gh / 4; const int dil = (g == 0) ? 1 : (g == 1 ? 4 : 16); const int b = t / S, s = t % S;
    __shared__ float qs[4][64]; __shared__ float ps[4][192];
    qs[wid][lane] = proj[(size_t)t * IN_COLS + QOFF + gh * 64 + lane];
    __syncthreads();
    float sc[3]; float mx = -3.0e38f;
#pragma unroll
    for (int p = 0; p < 3; ++p) {
        int j = p * 64 + lane - 64; int kp = s + j * dil; bool valid = (j <= 64) && kp >= 0 && kp < S; float a = -1e30f;
        if (valid) { const float* kr = proj + (size_t)(b * S + kp) * IN_COLS + KOFF + gh * 64; float acc = 0.f; for (int d = 0; d < 64; ++d) acc += qs[wid][d] * kr[d]; a = acc * 0.125f; }
        sc[p] = a; mx = fmaxf(mx, a);
    }
    mx = wmax(mx); float sum = 0.f;
#pragma unroll
    for (int p = 0; p < 3; ++p) { float e = (sc[p] > -1e29f) ? expf(sc[p] - mx) : 0.f; sc[p] = e; sum += e; }
    sum = wsum(sum);
#pragma unroll
    for (int p = 0; p < 3; ++p) ps[wid][p * 64 + lane] = sc[p];
    __syncthreads();
    float acc = 0.f;
    for (int jj = 0; jj < 129; ++jj) { int kp = s + (jj - 64) * dil; if (kp >= 0 && kp < S) acc += ps[wid][jj] * proj[(size_t)(b * S + kp) * IN_COLS + VOFF + gh * 64 + lane]; }
    outg[(size_t)t * 768 + gh * 64 + lane] = acc / sum;
    if (lane == 0) lse[(size_t)t * 12 + gh] = mx + logf(sum);
}
__global__ void k_attn_combine(const float* __restrict__ outg, const float* __restrict__ lse, float* __restrict__ attn) {
    size_t i = (size_t)blockIdx.x * blockDim.x + threadIdx.x; if (i >= (size_t)T * 256) return;
    int c = i % 256; int t = (int)(i / 256); int h = c / 64, d = c % 64;
    float l0 = lse[(size_t)t * 12 + h], l1 = lse[(size_t)t * 12 + 4 + h], l2 = lse[(size_t)t * 12 + 8 + h];
    float m = fmaxf(l0, fmaxf(l1, l2)); float e0 = expf(l0 - m), e1 = expf(l1 - m), e2 = expf(l2 - m), inv = 1.f / (e0 + e1 + e2);
    attn[i] = (e0 * outg[(size_t)t * 768 + h * 64 + d] + e1 * outg[(size_t)t * 768 + (4 + h) * 64 + d] + e2 * outg[(size_t)t * 768 + (8 + h) * 64 + d]) * inv;
}
__global__ void k_pool_diff(const float* __restrict__ proj, float* __restrict__ pd) {
    size_t i = (size_t)blockIdx.x * blockDim.x + threadIdx.x; if (i >= (size_t)T * 512) return;
    int c = i % 512; int t = (int)(i / 512); int g = c / 128; int half = 1 << g; int b = t / S, s = t % S;
    int lo = max(s - half, 0), hi = min(s + half, S); float sum = 0.f;
    for (int p = lo; p < hi; ++p) sum += proj[(size_t)(b * S + p) * IN_COLS + UOFF + c];
    pd[i] = sum / (float)(hi - lo) - proj[(size_t)t * IN_COLS + UOFF + c];
}
__global__ void k_pool_lin(const float* __restrict__ pd, const float* __restrict__ pw, const float* __restrict__ scale, float* __restrict__ py) {
    __shared__ float row[512]; const int t = blockIdx.x;
    for (int i = threadIdx.x; i < 512; i += 256) row[i] = pd[(size_t)t * 512 + i];
    __syncthreads();
    for (int o = threadIdx.x; o < 512; o += 256) { int g = o / 128, d = o % 128; float acc = 0.f; for (int c = 0; c < 128; ++c) acc += row[g * 128 + c] * pw[((size_t)g * 128 + c) * 128 + d]; py[(size_t)t * 512 + o] = acc * scale[o]; }
}
__global__ void k_merge(const float* __restrict__ proj, const float* __restrict__ aa, const float* __restrict__ pp, float* __restrict__ merged) {
    size_t i = (size_t)blockIdx.x * blockDim.x + threadIdx.x; if (i >= (size_t)T * D) return;
    int c = i % D; size_t t = i / D; float ga = proj[t * IN_COLS + GAOFF + c], gp = proj[t * IN_COLS + GPOFF + c];
    merged[i] = aa[i] / (1.f + expf(-ga)) + pp[i] / (1.f + expf(-gp));
}
__global__ void k_resid(float* __restrict__ x, const float* __restrict__ y, const float* __restrict__ gate) {
    size_t i = (size_t)blockIdx.x * blockDim.x + threadIdx.x; if (i >= (size_t)T * D) return;
    int c = i % D; int t = (int)(i / D); int b = t / S; x[i] += gate[(size_t)b * 6 * D + c] * y[i];
}
__global__ void __launch_bounds__(256) k_sgemm(const float* __restrict__ A, int lda, const int* __restrict__ ridx, const float* __restrict__ B, int ldb, size_t strideB,
                                                const float* __restrict__ bias, size_t strideBias, const int* __restrict__ tile_exp, float* __restrict__ C, int ldc, int K) {
    __shared__ float As[8][128 + 4]; __shared__ float Bs[8][128 + 4];
    const int tid = threadIdx.x, tm = blockIdx.y, tn = blockIdx.x; int e = 0;
    if (tile_exp) { e = tile_exp[tm]; if (e < 0) return; }
    const float* Bp = B + (size_t)e * strideB + (size_t)tn * 128;
    const int arow = tid >> 1, ak = (tid & 1) * 4; const int grow = tm * 128 + arow;
    const float* Ap = A + (size_t)(ridx ? ridx[grow] : grow) * lda + ak;
    const int bk = tid >> 5, bc = (tid & 31) * 4; const int ty = tid >> 4, tx = tid & 15;
    float acc[8][8];
#pragma unroll
    for (int i = 0; i < 8; ++i)
#pragma unroll
        for (int j = 0; j < 8; ++j) acc[i][j] = 0.f;
    for (int k0 = 0; k0 < K; k0 += 8) {
        float4 av = *(const float4*)(Ap + k0); float4 bv = *(const float4*)(Bp + (size_t)(k0 + bk) * ldb + bc);
        __syncthreads();
        As[ak + 0][arow] = av.x; As[ak + 1][arow] = av.y; As[ak + 2][arow] = av.z; As[ak + 3][arow] = av.w; *(float4*)&Bs[bk][bc] = bv;
        __syncthreads();
#pragma unroll
        for (int kk = 0; kk < 8; ++kk) {
            float a[8], b[8];
            *(float4*)&a[0] = *(const float4*)&As[kk][ty * 4]; *(float4*)&a[4] = *(const float4*)&As[kk][64 + ty * 4];
            *(float4*)&b[0] = *(const float4*)&Bs[kk][tx * 4]; *(float4*)&b[4] = *(const float4*)&Bs[kk][64 + tx * 4];
#pragma unroll
            for (int i = 0; i < 8; ++i)
#pragma unroll
                for (int j = 0; j < 8; ++j) acc[i][j] += a[i] * b[j];
        }
    }
    const float* bp = bias ? bias + (size_t)e * strideBias + tn * 128 : nullptr;
#pragma unroll
    for (int i = 0; i < 8; ++i) {
        int r = tm * 128 + (i < 4 ? ty * 4 + i : 64 + ty * 4 + i - 4);
#pragma unroll
        for (int jh = 0; jh < 2; ++jh) { int cc = jh * 64 + tx * 4;
            float4 o = make_float4(acc[i][jh * 4 + 0], acc[i][jh * 4 + 1], acc[i][jh * 4 + 2], acc[i][jh * 4 + 3]);
            if (bp) { o.x += bp[cc]; o.y += bp[cc + 1]; o.z += bp[cc + 2]; o.w += bp[cc + 3]; }
            *(float4*)(C + (size_t)r * ldc + tn * 128 + cc) = o; }
    }
}
__global__ void k_router(const float* __restrict__ h, const float* __restrict__ rw, const float* __restrict__ rb, int* __restrict__ top_e, float* __restrict__ top_g) {
    const int wid = threadIdx.x >> 6, lane = threadIdx.x & 63; const int t = blockIdx.x * 4 + wid; const int e = lane & 31, half = lane >> 5;
    const float* hr = h + (size_t)t * D + half * 512; const float* w = rw + (size_t)(half * 512) * NE + e;
    float acc = 0.f; for (int k = 0; k < 512; ++k) acc += hr[k] * w[(size_t)k * NE];
    acc += __shfl_xor(acc, 32); float logit = acc + rb[e];
    float vals[4]; int idx[4]; float cur = logit;
#pragma unroll
    for (int k = 0; k < 4; ++k) { float m = cur; int mi = e;
#pragma unroll
        for (int o = 16; o > 0; o >>= 1) { float om = __shfl_xor(m, o); int oi = __shfl_xor(mi, o); if (om > m || (om == m && oi < mi)) { m = om; mi = oi; } }
        vals[k] = m; idx[k] = mi; if (e == mi) cur = -3.0e38f; }
    float e0 = 1.f, e1 = expf(vals[1] - vals[0]), e2 = expf(vals[2] - vals[0]), e3 = expf(vals[3] - vals[0]); float inv = 1.f / (e0 + e1 + e2 + e3);
    if (lane == 0) { top_e[t * 4 + 0] = idx[0]; top_e[t * 4 + 1] = idx[1]; top_e[t * 4 + 2] = idx[2]; top_e[t * 4 + 3] = idx[3];
        top_g[t * 4 + 0] = e0 * inv; top_g[t * 4 + 1] = e1 * inv; top_g[t * 4 + 2] = e2 * inv; top_g[t * 4 + 3] = e3 * inv; }
}
__global__ void __launch_bounds__(1024) k_positions(const int* __restrict__ top_e, int* __restrict__ pos, int* __restrict__ cnt) {
    __shared__ int wsum_[16]; __shared__ int base_s;
    const int e = blockIdx.x, tid = threadIdx.x, wid = tid >> 6, lane = tid & 63;
    if (tid == 0) base_s = 0;
    __syncthreads();
    for (int a0 = 0; a0 < NASSIGN; a0 += 1024) {
        const int a = a0 + tid; const bool f = top_e[a] == e; const unsigned long long bal = __ballot(f);
        const int pre = __popcll(bal & ((1ull << lane) - 1ull));
        if (lane == 0) wsum_[wid] = __popcll(bal);
        __syncthreads();
        int off = base_s; for (int w = 0; w < wid; ++w) off += wsum_[w];
        if (f) pos[a] = off + pre;
        __syncthreads();
        if (tid == 0) { int s = 0; for (int w = 0; w < 16; ++w) s += wsum_[w]; base_s += s; }
        __syncthreads();
    }
    if (tid == 0) cnt[e] = base_s;
}
__global__ void k_assign(const int* __restrict__ top_e, const int* __restrict__ pos, const int* __restrict__ cnt, int* __restrict__ row_token, int* __restrict__ tok_row, int* __restrict__ tile_exp) {
    __shared__ int base[NE + 1];
    if (threadIdx.x == 0) { int s = 0; for (int e = 0; e < NE; ++e) { base[e] = s; s += (cnt[e] + RPAD - 1) / RPAD * RPAD; } base[NE] = s; }
    __syncthreads();
    const int i = blockIdx.x * blockDim.x + threadIdx.x;
    if (i < NASSIGN) { const int e = top_e[i]; const int row = base[e] + pos[i]; row_token[row] = i / TOPK; tok_row[i] = row; }
    if (i < NROWS_MAX) { int e = -1; for (int q = 0; q < NE; ++q) if (i >= base[q] && i < base[q + 1]) e = q;
        if (e >= 0 && i >= base[e] + cnt[e]) row_token[i] = 0;
        if ((i & 127) == 0) tile_exp[i >> 7] = e; }
}
__global__ void k_swiglu(const float* __restrict__ z, float* __restrict__ act, const int* __restrict__ tile_exp) {
    const int row = blockIdx.x; if (tile_exp[row >> 7] < 0) return;
    for (int j = threadIdx.x; j < D; j += 256) { float glu = fminf(z[(size_t)row * 2048 + j], 7.f); float lin = fminf(fmaxf(z[(size_t)row * 2048 + 1024 + j], -7.f), 7.f);
        act[(size_t)row * D + j] = glu / (1.f + expf(-1.702f * glu)) * (lin + 1.f); }
}
__global__ void k_moe_combine(float* __restrict__ x, const float* __restrict__ y, const int* __restrict__ tok_row, const float* __restrict__ top_g, const float* __restrict__ g2) {
    const int t = blockIdx.x, b = t / S, tid = threadIdx.x; float4 acc = make_float4(0.f, 0.f, 0.f, 0.f);
#pragma unroll
    for (int k = 0; k < 4; ++k) { const int row = tok_row[t * 4 + k]; const float gt = top_g[t * 4 + k]; float4 v = ((const float4*)(y + (size_t)row * D))[tid];
        acc.x += gt * v.x; acc.y += gt * v.y; acc.z += gt * v.z; acc.w += gt * v.w; }
    float4 gg = ((const float4*)(g2 + (size_t)b * 6 * D))[tid]; float4 xv = ((float4*)(x + (size_t)t * D))[tid];
    xv.x += gg.x * acc.x; xv.y += gg.y * acc.y; xv.z += gg.z * acc.z; xv.w += gg.w * acc.w; ((float4*)(x + (size_t)t * D))[tid] = xv;
}
__global__ void k_cmp(const uint4* __restrict__ a, const uint4* __restrict__ b, size_t n16, unsigned* __restrict__ cnt) {
    size_t i = (size_t)blockIdx.x * blockDim.x + threadIdx.x; const size_t st = (size_t)gridDim.x * blockDim.x; unsigned c = 0;
    for (; i < n16; i += st) { const uint4 x = a[i], y = b[i]; c += (x.x != y.x || x.y != y.y || x.z != y.z || x.w != y.w) ? 1u : 0u; }
    if (c) atomicAdd(cnt, c);
}
__global__ void k_emit(float* __restrict__ out, const unsigned* __restrict__ cnt, int n, size_t total) {
    float v = 0.f; for (int p = n - 1; p >= 0; --p) if (cnt[p] != 0u) v = (float)(p + 1);
    size_t i = (size_t)blockIdx.x * blockDim.x + threadIdx.x; const size_t st = (size_t)gridDim.x * blockDim.x;
    for (; i < total; i += st) out[i] = v;
}
__global__ void k_fp(const float* __restrict__ x, size_t n, double* __restrict__ fp) {
    __shared__ double red[3][256];
    double s1 = 0, s2 = 0, s3 = 0; size_t i = (size_t)blockIdx.x * blockDim.x + threadIdx.x; const size_t st = (size_t)gridDim.x * blockDim.x;
    for (; i < n; i += st) { const double v = (double)x[i]; s1 += v; s2 += v * v; s3 += v * (double)(((unsigned)i * 2654435761u >> 8) & 0xffffu) * (1.0 / 65536.0); }
    red[0][threadIdx.x] = s1; red[1][threadIdx.x] = s2; red[2][threadIdx.x] = s3; __syncthreads();
    for (int o = 128; o > 0; o >>= 1) { if ((int)threadIdx.x < o) { red[0][threadIdx.x] += red[0][threadIdx.x + o]; red[1][threadIdx.x] += red[1][threadIdx.x + o]; red[2][threadIdx.x] += red[2][threadIdx.x + o]; } __syncthreads(); }
    if (threadIdx.x == 0) { atomicAdd(fp + 0, red[0][0]); atomicAdd(fp + 1, red[1][0]); atomicAdd(fp + 2, red[2][0]); }
}
__global__ void k_relerr(const unsigned short* __restrict__ b, int ldb, const float* __restrict__ ref, int ldr, int ncols, double* __restrict__ acc2) {
    __shared__ double red[2][256];
    double d2 = 0, r2 = 0; const size_t n = (size_t)T * ncols; size_t i = (size_t)blockIdx.x * blockDim.x + threadIdx.x; const size_t st = (size_t)gridDim.x * blockDim.x;
    for (; i < n; i += st) { const size_t t = i / ncols; const int c = (int)(i % ncols); const float bv = __builtin_bit_cast(float, (unsigned)b[t * ldb + c] << 16), rv = ref[t * ldr + c]; d2 += (double)(bv - rv) * (bv - rv); r2 += (double)rv * rv; }
    red[0][threadIdx.x] = d2; red[1][threadIdx.x] = r2; __syncthreads();
    for (int o = 128; o > 0; o >>= 1) { if ((int)threadIdx.x < o) { red[0][threadIdx.x] += red[0][threadIdx.x + o]; red[1][threadIdx.x] += red[1][threadIdx.x + o]; } __syncthreads(); }
    if (threadIdx.x == 0) { atomicAdd(acc2, red[0][0]); atomicAdd(acc2 + 1, red[1][0]); }
}
__global__ void k_emit_err(float* __restrict__ out, const double* __restrict__ acc, size_t total) {
    const float ka = 100.f * (float)sqrt(acc[0] / acc[1]), kb = 100.f + 1000.f * (float)sqrt(acc[2] / acc[3]);
    size_t i = (size_t)blockIdx.x * blockDim.x + threadIdx.x; const size_t st = (size_t)gridDim.x * blockDim.x;
    for (; i < total; i += st) out[i] = (i == 0) ? kb : ka;
}
__global__ void k_rowfp(const float* __restrict__ x, double* __restrict__ fp  , const double* __restrict__ ref  , unsigned* __restrict__ cnt) {
    const int t = blockIdx.x * 4 + (threadIdx.x >> 6), lane = threadIdx.x & 63; double s2 = 0, s3 = 0;
    for (int j = lane; j < D; j += 64) { const double v = (double)x[(size_t)t * D + j]; s2 += v * v; s3 += v * (double)((j * 37 + 11) % 64 + 1); }
    for (int o = 32; o > 0; o >>= 1) { s2 += __shfl_xor(s2, o); s3 += __shfl_xor(s3, o); }
    if (lane == 0) {
        if (!ref) { fp[t * 2] = s2; fp[t * 2 + 1] = s3; }
        else { const double a2 = ref[t * 2], a3 = ref[t * 2 + 1]; const bool bad = !(fabs(a2 - s2) <= 1e-5 * (fabs(a2) + fabs(s2))) || !(fabs(a3 - s3) <= 1e-5 * sqrt(fabs(a2) + fabs(s2)) * 40.0); if (bad) atomicAdd(cnt, 1u); }
    }
}
__global__ void k_emit3(float* __restrict__ out, const unsigned* __restrict__ cnt, int nchk, size_t total) {
    float v = 0.f;
    for (int c = nchk - 1; c >= 0; --c) if (cnt[c] != 0u) v = (float)(c + 1) + (cnt[c] < 32u ? 0.f : (cnt[c] < 3277u ? 0.3f : 0.6f));
    size_t i = (size_t)blockIdx.x * blockDim.x + threadIdx.x; const size_t st = (size_t)gridDim.x * blockDim.x;
    for (; i < total; i += st) out[i] = v;
}
__global__ void k_emit2(float* __restrict__ out, const double* __restrict__ fp, int nchk, size_t total) {
    float v = 0.f;
    for (int c = nchk - 1; c >= 0; --c) { bool bad = false;
        for (int q = 0; q < 3; ++q) { const double a = fp[c * 3 + q], b = fp[(nchk + c) * 3 + q]; const double d = fabs(a - b), m = fabs(a) + fabs(b) + 1e-30; if (!(d <= 1e-7 * m)) bad = true; }
        if (bad) v = (float)(c + 1); }
    size_t i = (size_t)blockIdx.x * blockDim.x + threadIdx.x; const size_t st = (size_t)gridDim.x * blockDim.x;
    for (; i < total; i += st) out[i] = v;
}
}
#endif

extern "C" void kernel_launch(void* const* d_in, const int* in_sizes, int n_in, void* d_out, int out_size, void* d_ws, size_t ws_size, hipStream_t stream) {
    using namespace mk;
    static int grid = 0;
    if (grid == 0) {
        int dev = 0, cus = 0;
        if (n_in != 19 || out_size != T * D || ws_size < WS_END) { fprintf(stderr, "kernel_launch: unexpected problem (n_in %d out %d ws %zu need %zu)\n", n_in, out_size, ws_size, (size_t)WS_END); grid = -1; return; }
        if (hipGetDevice(&dev) != hipSuccess || hipDeviceGetAttribute(&cus, hipDeviceAttributeMultiprocessorCount, dev) != hipSuccess) { grid = -1; return; }
        if (hipFuncSetAttribute((const void*)mega_fwd, hipFuncAttributeMaxDynamicSharedMemorySize, LDS_BYTES) != hipSuccess) { fprintf(stderr, "kernel_launch: hipFuncSetAttribute failed\n"); grid = -1; return; }
        int per_cu = 0;
        if (hipOccupancyMaxActiveBlocksPerMultiprocessor(&per_cu, (const void*)mega_fwd, NTHREADS, LDS_BYTES) != hipSuccess || per_cu < 1) { fprintf(stderr, "kernel_launch: occupancy query says %d\n", per_cu); (void)hipGetLastError(); }
        if (cus < GRID) { fprintf(stderr, "kernel_launch: needs %d CUs, device has %d\n", GRID, cus); grid = -1; return; }
        grid = GRID;
    }
    if (grid < 0) return;
    (void)hipMemsetAsync((char*)d_ws + WS_CTL, 0, MODE == 0 ? (size_t)(CW_BAR + BAR_REGION_WORDS) * 4 : ZERO_BYTES, stream);
#if MODE != 0
    (void)hipMemsetAsync((char*)d_ws + ZERO_BYTES, 0xFF, ws_size - ZERO_BYTES, stream);
#endif
    Args a{};
    for (int i = 0; i < 19; ++i) a.in[i] = (const float*)d_in[i];
    a.out = (float*)d_out; a.ws = (unsigned char*)d_ws;
    int li = 0;
    auto launch = [&](int lo, int hi, int flags) { a.ph_lo = lo; a.ph_hi = hi; a.li = li++; a.flags = flags; hipLaunchKernelGGL(mega_fwd, dim3(grid), dim3(NTHREADS), LDS_BYTES, stream, a); };
#if MODE == 0
    launch(0, NPHASE, 0);
#elif MODE == 3
    for (int p = 0; p < NPHASE; ++p) launch(p, p + 1, 0);
#elif MODE == 7
    {
        using namespace nv;
        const float* x_in = (const float*)d_in[0]; char* ws = (char*)d_ws; size_t off = WS_END;
        auto carve = [&](size_t bytes) { char* p = ws + off; off += (bytes + 255) & ~(size_t)255; return p; };
        float* h = (float*)carve((size_t)T * D * 4); float* mod = (float*)carve((size_t)DEPTH * NB * 6 * D * 4); float* ropecs = (float*)carve((size_t)S * 16 * 4);
        float* proj = (float*)carve((size_t)T * IN_COLS * 4); float* outg = (float*)carve((size_t)T * 768 * 4); float* lse = (float*)carve((size_t)T * 12 * 4);
        float* attn = (float*)carve((size_t)T * 256 * 4); float* pd = (float*)carve((size_t)T * 512 * 4);
        if (off > ws_size) { fprintf(stderr, "ws too small for probe\n"); return; }
        double* acc = (double*)(ws + WS_CTL + 8192);
        k_mod<<<dim3(6 * D / 256, DEPTH), 256, 0, stream>>>((const float*)d_in[1], (const float*)d_in[2], (const float*)d_in[3], mod);
        k_rope_table<<<(S * 8 + 255) / 256, 256, 0, stream>>>(ropecs);
        k_norm_mod<<<T, 256, 0, stream>>>(x_in, (const float*)d_in[4], mod + 0 * D, mod + 1 * D, h);
        k_sgemm<<<dim3(IN_COLS / 128, T / 128), 256, 0, stream>>>(h, D, nullptr, (const float*)d_in[5], IN_COLS, 0, nullptr, 0, nullptr, proj, IN_COLS, D);
        k_rope<<<(unsigned)(((size_t)T * 2 * 12 * 8 + 255) / 256), 256, 0, stream>>>(proj, ropecs);
        k_attn<<<T * 12 / 4, 256, 0, stream>>>(proj, outg, lse);
        k_attn_combine<<<(unsigned)(((size_t)T * 256 + 255) / 256), 256, 0, stream>>>(outg, lse, attn);
        k_pool_diff<<<(unsigned)(((size_t)T * 512 + 255) / 256), 256, 0, stream>>>(proj, pd);
        launch(0, 1, 0);
        for (int p = 1; p <= 4; ++p) launch(p, p + 1, 0);
        k_relerr<<<2048, 256, 0, stream>>>((const unsigned short*)(ws + WS_AD), 768, attn, 256, 256, acc);
        k_relerr<<<2048, 256, 0, stream>>>((const unsigned short*)(ws + WS_AD) + 256, 768, pd, 512, 512, acc + 2);
        k_emit_err<<<2048, 256, 0, stream>>>((float*)d_out, acc, (size_t)T * D);
    }
#elif MODE == 5
    {
        using namespace nv;
        char* ws = (char*)d_ws; unsigned* cnt = (unsigned*)(ws + WS_CTL) + 1024;
        const size_t nx = (size_t)T * D;
        struct Reg { size_t off, bytes; };
        const Reg regs[7] = {{WS_H, (size_t)T * D * 2}, {WS_Q, WS_OG - WS_Q}, {WS_OG, WS_AD - WS_OG}, {WS_AD, (size_t)T * 768 * 2}, {WS_MA, (size_t)T * D * 2}, {WS_MG, (size_t)T * D * 2}, {WS_X, (size_t)T * D * 4}};
        size_t snap[7]; size_t o = WS_END; for (int p = 0; p < 7; ++p) { snap[p] = o; o += (regs[p].bytes + 4095) & ~(size_t)4095; }
        if (o > ws_size) { fprintf(stderr, "ws too small for probe\n"); return; }
        for (int run = 0; run < 2; ++run) {
            if (run == 1) { (void)hipMemsetAsync(ws + WS_MOD, 0, MOD_BYTES, stream); (void)hipMemsetAsync(ws + ZERO_BYTES, 0x55, WS_END - ZERO_BYTES, stream); }
            launch(0, 1, 0);
            k_copy<<<(unsigned)((nx / 4 + 255) / 256), 256, 0, stream>>>((const float*)d_in[0], (float*)(ws + WS_X), nx / 4);
            for (int p = 0; p < 7; ++p) {
                launch(1 + p, 2 + p, 1 | (run ? 16 : 0));
                if (run == 0) (void)hipMemcpyAsync(ws + snap[p], ws + regs[p].off, regs[p].bytes, hipMemcpyDeviceToDevice, stream);
                else k_cmp<<<2048, 256, 0, stream>>>((const uint4*)(ws + snap[p]), (const uint4*)(ws + regs[p].off), regs[p].bytes / 16, cnt + p);
            }
        }
        k_emit<<<2048, 256, 0, stream>>>((float*)d_out, cnt, 7, nx);
    }
#else
    for (int run = 0; run < (MODE == 6 ? 2 : 1); ++run) {
        using namespace nv;
        const size_t fp_bytes = (size_t)9 * T * 2 * 8; double* rowfp = (double*)((char*)d_ws + ws_size - fp_bytes); unsigned* rcnt = (unsigned*)((char*)d_ws + WS_CTL + 8192);
        if (run == 1) { (void)hipMemsetAsync((char*)d_ws + WS_MOD, 0, MOD_BYTES, stream); (void)hipMemsetAsync((char*)d_ws + ZERO_BYTES, 0x55, ws_size - ZERO_BYTES - fp_bytes, stream); }
        const float* x_in = (const float*)d_in[0]; const float* c = (const float*)d_in[1]; const float* ada_w = (const float*)d_in[2]; const float* ada_b = (const float*)d_in[3];
        const float* norm1_g = (const float*)d_in[4]; const float* w_in = (const float*)d_in[5]; const float* pool_w = (const float*)d_in[6]; const float* pool_scale = (const float*)d_in[7];
        const float* w_ab = (const float*)d_in[8]; const float* w_pb = (const float*)d_in[9]; const float* w_out = (const float*)d_in[10]; const float* norm2_g = (const float*)d_in[11];
        const float* router_w = (const float*)d_in[12]; const float* router_b = (const float*)d_in[13]; const float* w_gu = (const float*)d_in[14]; const float* b_gu = (const float*)d_in[15];
        const float* w_down = (const float*)d_in[16]; const float* b_down = (const float*)d_in[17]; const float* final_g = (const float*)d_in[18];
        float* out = (float*)d_out;
        char* ws = (char*)d_ws; size_t off = WS_ACT;
        auto carve = [&](size_t bytes) { char* p = ws + off; off += (bytes + 255) & ~(size_t)255; return p; };
        char* actr = carve((size_t)NROWS_MAX * D * 4);
        if (off < WS_END) off = WS_END;
        float* x = (float*)(ws + WS_X);
        float* h = (float*)carve((size_t)T * D * 4);
        float* mod = (float*)carve((size_t)DEPTH * NB * 6 * D * 4);
        float* ropecs = (float*)carve((size_t)S * 16 * 4);
        int* top_e = (int*)carve((size_t)NASSIGN * 4); float* top_g = (float*)carve((size_t)NASSIGN * 4);
        int* pos = (int*)carve((size_t)NASSIGN * 4); int* cnt = (int*)carve(256);
        int* row_token = (int*)carve((size_t)NROWS_MAX * 4); int* tok_row = (int*)carve((size_t)NASSIGN * 4); int* tile_exp = (int*)carve((size_t)(NROWS_MAX / 128) * 4);
        char* big = carve((size_t)NROWS_MAX * 2048 * 4);
        float* y = (float*)carve((size_t)NROWS_MAX * D * 4);
        float* z = (float*)big;
        float* proj = (float*)big; float* outg = proj + (size_t)T * IN_COLS; float* Aa = outg + (size_t)T * 768; float* Pp = Aa + (size_t)T * D;
        float* act = (float*)actr;
        float* merged = (float*)actr; float* mo = merged + (size_t)T * D; float* attn = mo + (size_t)T * D; float* pd = attn + (size_t)T * 256; float* py = pd + (size_t)T * 512; float* lse = py + (size_t)T * 512;
        if (off > ws_size) { fprintf(stderr, "ws too small: need %zu have %zu\n", off, ws_size); return; }
        const size_t nx = (size_t)T * D;
        k_copy<<<(unsigned)((nx / 4 + 255) / 256), 256, 0, stream>>>(x_in, x, nx / 4);
        k_mod<<<dim3(6 * D / 256, DEPTH), 256, 0, stream>>>(c, ada_w, ada_b, mod);
        k_rope_table<<<(S * 8 + 255) / 256, 256, 0, stream>>>(ropecs);
        launch(0, 1, 0);
        for (int l = 0; l < DEPTH; ++l) {
            const float* ml = mod + (size_t)l * NB * 6 * D;
            const int pb = 1 + l * PH_PER_LAYER;
            if (MODE == 1) {
                launch(pb, pb + 7, 1);
            } else if (MODE == 4 || MODE == 6) {
                for (int p = pb; p < pb + 7; ++p) launch(p, p + 1, 1);
            } else {
                k_norm_mod<<<T, 256, 0, stream>>>(x, norm1_g + l * D, ml + 0 * D, ml + 1 * D, h);
                k_sgemm<<<dim3(IN_COLS / 128, T / 128), 256, 0, stream>>>(h, D, nullptr, w_in + (size_t)l * D * IN_COLS, IN_COLS, 0, nullptr, 0, nullptr, proj, IN_COLS, D);
                k_rope<<<(unsigned)(((size_t)T * 2 * 12 * 8 + 255) / 256), 256, 0, stream>>>(proj, ropecs);
                k_attn<<<T * 12 / 4, 256, 0, stream>>>(proj, outg, lse);
                k_attn_combine<<<(unsigned)(((size_t)T * 256 + 255) / 256), 256, 0, stream>>>(outg, lse, attn);
                k_pool_diff<<<(unsigned)(((size_t)T * 512 + 255) / 256), 256, 0, stream>>>(proj, pd);
                k_pool_lin<<<T, 256, 0, stream>>>(pd, pool_w + (size_t)l * 4 * 128 * 128, pool_scale + l * 512, py);
                k_sgemm<<<dim3(D / 128, T / 128), 256, 0, stream>>>(attn, 256, nullptr, w_ab + (size_t)l * 256 * D, D, 0, nullptr, 0, nullptr, Aa, D, 256);
                k_sgemm<<<dim3(D / 128, T / 128), 256, 0, stream>>>(py, 512, nullptr, w_pb + (size_t)l * 512 * D, D, 0, nullptr, 0, nullptr, Pp, D, 512);
                k_merge<<<(unsigned)((nx + 255) / 256), 256, 0, stream>>>(proj, Aa, Pp, merged);
                k_sgemm<<<dim3(D / 128, T / 128), 256, 0, stream>>>(merged, D, nullptr, w_out + (size_t)l * D * D, D, 0, nullptr, 0, nullptr, mo, D, D);
                k_resid<<<(unsigned)((nx + 255) / 256), 256, 0, stream>>>(x, mo, ml + 2 * D);
            }
            if (MODE == 6) k_rowfp<<<T / 4, 256, 0, stream>>>(x, rowfp + (size_t)(2 * l) * T * 2, run ? rowfp + (size_t)(2 * l) * T * 2 : nullptr, rcnt + 2 * l);
            if (MODE == 2) {
                launch(pb + 7, pb + 11, 0);
                launch(PH_FINAL, PH_FINAL + 1, 2 | (l << 8));
            } else {
                k_norm_mod<<<T, 256, 0, stream>>>(x, norm2_g + l * D, ml + 3 * D, ml + 4 * D, h);
                k_router<<<T / 4, 256, 0, stream>>>(h, router_w + (size_t)l * D * NE, router_b + l * NE, top_e, top_g);
                k_positions<<<NE, 1024, 0, stream>>>(top_e, pos, cnt);
                k_assign<<<(NROWS_MAX + 255) / 256, 256, 0, stream>>>(top_e, pos, cnt, row_token, tok_row, tile_exp);
                k_sgemm<<<dim3(2048 / 128, NROWS_MAX / 128), 256, 0, stream>>>(h, D, row_token, w_gu + (size_t)l * NE * D * 2048, 2048, (size_t)D * 2048, b_gu + (size_t)l * NE * 2048, 2048, tile_exp, z, 2048, D);
                k_swiglu<<<NROWS_MAX, 256, 0, stream>>>(z, act, tile_exp);
                k_sgemm<<<dim3(D / 128, NROWS_MAX / 128), 256, 0, stream>>>(act, D, nullptr, w_down + (size_t)l * NE * D * D, D, (size_t)D * D, b_down + (size_t)l * NE * D, D, tile_exp, y, D, D);
                k_moe_combine<<<T, 256, 0, stream>>>(x, y, tok_row, top_g, ml + 5 * D);
            }
            if (MODE == 6) k_rowfp<<<T / 4, 256, 0, stream>>>(x, rowfp + (size_t)(2 * l + 1) * T * 2, run ? rowfp + (size_t)(2 * l + 1) * T * 2 : nullptr, rcnt + 2 * l + 1);
        }
        k_norm_mod<<<T, 256, 0, stream>>>(x, final_g, nullptr, nullptr, out);
        if (MODE == 6) { k_rowfp<<<T / 4, 256, 0, stream>>>(out, rowfp + (size_t)8 * T * 2, run ? rowfp + (size_t)8 * T * 2 : nullptr, rcnt + 8); if (run == 1) k_emit3<<<2048, 256, 0, stream>>>(out, rcnt, 9, nx); }
    }
#endif
}
```
